# Optimizing an MI355X kernel written in HIP

```python
import math
import jax
import jax.numpy as jnp
from jax import lax
import numpy as np

D_MODEL = 1024
BATCH = 2
SEQ = 8192
DEPTH = 2

HEAD_DIM = 64
N_HEADS_SB = 8
N_HEADS_NSA = 8
NSA_KV_GROUPS = 2
NSA_HPG = N_HEADS_NSA // NSA_KV_GROUPS
W_SB = N_HEADS_SB * HEAD_DIM
W_NSA = N_HEADS_NSA * HEAD_DIM
CMP_BLOCK = 32
CMP_STRIDE = 16
CMP_HIDDEN = 256
SLC_BLOCK = 64
N_SELECT = 16
WINDOW = 512
Q_BLOCK = 128
REL_BUCKETS = 32
REL_MAX_DIST = 128
D_FF_DENSE = 2816
N_EXPERTS = 8
TOP_K = 2
D_FF_EXPERT = 3584
MOE_ROW_BLOCK = 256
NORM_EPS = 1e-6
FORCED_BLOCK_SCORE = 1e4
N_DENSE_LAYERS = (DEPTH + 1) // 2
N_MOE_LAYERS = DEPTH // 2

OFF_SB_Q = 0
OFF_SB_K = OFF_SB_Q + W_SB
OFF_SB_V = OFF_SB_K + W_SB
OFF_NSA_Q = OFF_SB_V + W_SB
OFF_NSA_KV = OFF_NSA_Q + W_NSA
OFF_NSA_GATE = OFF_NSA_KV + 3 * 2 * NSA_KV_GROUPS * HEAD_DIM
IN_COLS = OFF_NSA_GATE + 3 * N_HEADS_NSA

kernel_name = "hybrid_sb_nsa_moe_block"


def rms_norm(x, gain):
    xf = x.astype(jnp.float32)
    y = xf * lax.rsqrt(jnp.mean(xf * xf, axis=-1, keepdims=True) + NORM_EPS)
    return (y * gain.astype(jnp.float32)).astype(x.dtype)


def t5_bucket(dist):
    n = jnp.maximum(dist, 0)
    max_exact = REL_BUCKETS // 2
    large = max_exact + (jnp.log(jnp.maximum(n, 1).astype(jnp.float32) / max_exact)
                         / math.log(REL_MAX_DIST / max_exact)
                         * (REL_BUCKETS - max_exact)).astype(jnp.int32)
    large = jnp.minimum(large, REL_BUCKETS - 1)
    return jnp.where(n < max_exact, n, large)


def masked_softmax(logits, mask):
    logits = jnp.where(mask, logits, -jnp.inf)
    m = jnp.max(logits, axis=-1, keepdims=True)
    m = jnp.where(jnp.isfinite(m), m, 0.0)
    p = jnp.where(mask, jnp.exp(logits - m), 0.0)
    return p / jnp.maximum(jnp.sum(p, axis=-1, keepdims=True), 1e-30)


def stick_breaking_attention(q, k, v):
    B, H, S, dh = q.shape
    nq = S // Q_BLOCK
    scale = dh ** -0.5
    q_blocks = jnp.moveaxis(q.reshape(B, H, nq, Q_BLOCK, dh), 2, 0)
    key_pos = jnp.arange(S, dtype=jnp.int32)

    def one_block(args):
        qb, blk = args
        t = blk * Q_BLOCK + jnp.arange(Q_BLOCK, dtype=jnp.int32)
        mask = key_pos[None, :] < t[:, None]
        z = jnp.einsum('bhqd,bhkd->bhqk', qb, k) * scale
        log_keep = jnp.where(mask, jax.nn.log_sigmoid(-z), 0.0)
        later = lax.cumsum(log_keep, axis=3, reverse=True) - log_keep
        w = jnp.where(mask, jnp.exp(jax.nn.log_sigmoid(z) + later), 0.0)
        return jnp.einsum('bhqk,bhkd->bhqd', w, v)

    out = lax.map(one_block, (q_blocks, jnp.arange(nq, dtype=jnp.int32)))
    return jnp.moveaxis(out, 0, 2).reshape(B, H, S, dh)


def compress_tokens(k, pos_emb, w1, w2):
    B, G, S, dh = k.shape
    n_cmp = (S - CMP_BLOCK) // CMP_STRIDE + 1
    idx = jnp.arange(n_cmp)[:, None] * CMP_STRIDE + jnp.arange(CMP_BLOCK)[None, :]
    blocks = k[:, :, idx] + pos_emb
    flat = blocks.reshape(B, G, n_cmp, CMP_BLOCK * dh)
    return (jax.nn.gelu(flat @ w1) @ w2).astype(jnp.float32)


def native_sparse_attention(q, k_cmp_raw, v_cmp_raw, k_slc, v_slc, k_win, v_win, gates,
                            rel_table, cmp_pos_k, cmp_w1_k, cmp_w2_k,
                            cmp_pos_v, cmp_w1_v, cmp_w2_v):
    B, G, Z, S, dh = q.shape
    scale = dh ** -0.5
    nq = S // Q_BLOCK
    n_slc = S // SLC_BLOCK
    n_sel = min(N_SELECT, n_slc)

    k_c = compress_tokens(k_cmp_raw, cmp_pos_k, cmp_w1_k, cmp_w2_k)
    v_c = compress_tokens(v_cmp_raw, cmp_pos_v, cmp_w1_v, cmp_w2_v)
    n_cmp = k_c.shape[2]
    cmp_start = jnp.arange(n_cmp, dtype=jnp.int32) * CMP_STRIDE
    cmp_end = cmp_start + CMP_BLOCK - 1
    slc_start = jnp.arange(n_slc, dtype=jnp.int32) * SLC_BLOCK
    overlap = ((cmp_start[:, None] < slc_start[None, :] + SLC_BLOCK)
               & (cmp_start[:, None] + CMP_BLOCK > slc_start[None, :])).astype(jnp.float32)

    k_blocks = k_slc.reshape(B, G, n_slc, SLC_BLOCK, dh)
    v_blocks = v_slc.reshape(B, G, n_slc, SLC_BLOCK, dh)
    k_win_pad = jnp.pad(k_win, ((0, 0), (0, 0), (WINDOW, 0), (0, 0)))
    v_win_pad = jnp.pad(v_win, ((0, 0), (0, 0), (WINDOW, 0), (0, 0)))

    table_hd = rel_table.reshape(REL_BUCKETS, G, Z)
    table_g = jnp.transpose(table_hd, (1, 0, 2))
    bi = jnp.arange(B)[:, None, None, None]
    gi = jnp.arange(G)[None, :, None, None]
    in_blk = jnp.arange(SLC_BLOCK, dtype=jnp.int32)
    win_off = jnp.arange(Q_BLOCK + WINDOW, dtype=jnp.int32) - WINDOW
    blk_ids = jnp.arange(n_slc, dtype=jnp.int32)[None, :]

    q_blocks = jnp.moveaxis(q.reshape(B, G, Z, nq, Q_BLOCK, dh), 3, 0)
    g_blocks = jnp.moveaxis(gates.reshape(B, G, Z, nq, Q_BLOCK, 3), 3, 0)

    def head_bias(dist):
        return jnp.transpose(table_hd[t5_bucket(dist)], (2, 3, 0, 1))

    def one_block(args):
        qb, gb, blk = args
        c0 = blk * Q_BLOCK
        t = c0 + jnp.arange(Q_BLOCK, dtype=jnp.int32)

        dist_c = t[:, None] - cmp_end[None, :]
        logit_c = jnp.einsum('bgzqd,bgnd->bgzqn', qb, k_c) * scale + head_bias(dist_c)
        p_c = masked_softmax(logit_c, dist_c >= 0)
        o_c = jnp.einsum('bgzqn,bgnd->bgzqd', p_c, v_c)

        imp = jnp.einsum('bgzqn,nj->bgqj', p_c, overlap)
        valid = slc_start[None, :] <= t[:, None]
        cur = (t // SLC_BLOCK)[:, None]
        forced = valid & ((blk_ids == 0) | (blk_ids == cur) | (blk_ids == cur - 1))
        score = jnp.where(valid, imp + jnp.where(forced, FORCED_BLOCK_SCORE, 0.0), -1.0)
        top_score, top_idx = lax.top_k(score, n_sel)
        k_sel = k_blocks[bi, gi, top_idx]
        v_sel = v_blocks[bi, gi, top_idx]
        tok = top_idx[..., None] * SLC_BLOCK + in_blk
        dist_s = t[None, None, :, None, None] - tok
        mask_s = (top_score >= 0.0)[..., None] & (dist_s >= 0)
        bias_s = jnp.moveaxis(table_g[gi[..., None], t5_bucket(dist_s)], -1, 2)
        logit_s = jnp.einsum('bgzqd,bgqnld->bgzqnl', qb, k_sel) * scale + bias_s
        n_tok = n_sel * SLC_BLOCK
        p_s = masked_softmax(logit_s.reshape(B, G, Z, Q_BLOCK, n_tok),
                             mask_s.reshape(B, G, 1, Q_BLOCK, n_tok))
        o_s = jnp.einsum('bgzqm,bgqmd->bgzqd', p_s, v_sel.reshape(B, G, Q_BLOCK, n_tok, dh))

        k_w = lax.dynamic_slice_in_dim(k_win_pad, c0, Q_BLOCK + WINDOW, axis=2)
        v_w = lax.dynamic_slice_in_dim(v_win_pad, c0, Q_BLOCK + WINDOW, axis=2)
        pos_w = c0 + win_off
        dist_w = t[:, None] - pos_w[None, :]
        mask_w = (dist_w >= 0) & (dist_w < WINDOW) & (pos_w[None, :] >= 0)
        logit_w = jnp.einsum('bgzqd,bgkd->bgzqk', qb, k_w) * scale + head_bias(dist_w)
        p_w = masked_softmax(logit_w, mask_w)
        o_w = jnp.einsum('bgzqk,bgkd->bgzqd', p_w, v_w)

        return gb[..., 0:1] * o_c + gb[..., 1:2] * o_s + gb[..., 2:3] * o_w

    out = lax.map(one_block, (q_blocks, g_blocks, jnp.arange(nq, dtype=jnp.int32)))
    return jnp.transpose(out, (1, 0, 4, 2, 3, 5)).reshape(B, S, G * Z * dh)


def hybrid_mixer(h, w_in, w_out, g_sb, g_nsa, rel_table, cmp_pos_k, cmp_w1_k, cmp_w2_k,
                 cmp_pos_v, cmp_w1_v, cmp_w2_v):
    B, S, _ = h.shape
    G, Z, dh = NSA_KV_GROUPS, NSA_HPG, HEAD_DIM
    proj = (h @ w_in).astype(jnp.float32)

    def heads(lo, n):
        return proj[..., lo:lo + n * dh].reshape(B, S, n, dh).transpose(0, 2, 1, 3)

    o_sb = stick_breaking_attention(heads(OFF_SB_Q, N_HEADS_SB), heads(OFF_SB_K, N_HEADS_SB),
                                    heads(OFF_SB_V, N_HEADS_SB))
    o_sb = o_sb.transpose(0, 2, 1, 3).reshape(B, S, W_SB)

    q_nsa = proj[..., OFF_NSA_Q:OFF_NSA_KV].reshape(B, S, G, Z, dh).transpose(0, 2, 3, 1, 4)
    kv = proj[..., OFF_NSA_KV:OFF_NSA_GATE].reshape(B, S, 3, 2, G, dh).transpose(2, 3, 0, 4, 1, 5)
    gates = jax.nn.sigmoid(proj[..., OFF_NSA_GATE:IN_COLS]).reshape(B, S, G, Z, 3)
    gates = gates.transpose(0, 2, 3, 1, 4)
    o_nsa = native_sparse_attention(q_nsa, kv[0, 0], kv[0, 1], kv[1, 0], kv[1, 1],
                                    kv[2, 0], kv[2, 1], gates, rel_table,
                                    cmp_pos_k, cmp_w1_k, cmp_w2_k, cmp_pos_v, cmp_w1_v, cmp_w2_v)

    merged = jnp.concatenate([rms_norm(o_sb, g_sb), rms_norm(o_nsa, g_nsa)], axis=-1)
    return merged.astype(h.dtype) @ w_out


def swiglu(h, w_gate, w_up, w_down):
    return (jax.nn.silu(h @ w_gate) * (h @ w_up)) @ w_down


def moe_swiglu(h, w_router, b_router, w_gate, w_up, w_down):
    T, D = h.shape
    logits = h.astype(jnp.float32) @ w_router.astype(jnp.float32) + b_router.astype(jnp.float32)
    probs = jax.nn.softmax(logits, axis=-1)
    top_p, top_e = lax.top_k(probs, TOP_K)
    top_p = top_p / jnp.sum(top_p, axis=-1, keepdims=True)

    n_assign = T * TOP_K
    flat_e = top_e.reshape(-1)
    flat_tok = jnp.arange(n_assign, dtype=jnp.int32) // TOP_K
    order = jnp.argsort(flat_e)
    sorted_e = flat_e[order]
    sorted_tok = flat_tok[order]
    sorted_w = top_p.reshape(-1)[order]

    counts = jnp.bincount(flat_e, length=N_EXPERTS)
    padded = (counts + MOE_ROW_BLOCK - 1) // MOE_ROW_BLOCK * MOE_ROW_BLOCK
    start = jnp.cumsum(counts) - counts
    pad_end = jnp.cumsum(padded)
    pad_start = pad_end - padded
    dest = pad_start[sorted_e] + jnp.arange(n_assign, dtype=jnp.int32) - start[sorted_e]
    n_blocks = -(-n_assign // MOE_ROW_BLOCK) + N_EXPERTS
    row_tok = jnp.zeros((n_blocks * MOE_ROW_BLOCK,), jnp.int32).at[dest].set(sorted_tok)
    block_expert = jnp.minimum(
        jnp.searchsorted(pad_end, jnp.arange(n_blocks, dtype=jnp.int32) * MOE_ROW_BLOCK, side='right'),
        N_EXPERTS - 1)
    rows = h[row_tok].reshape(n_blocks, MOE_ROW_BLOCK, D)

    def expert_block(args):
        xb, e = args
        return swiglu(xb, w_gate[e], w_up[e], w_down[e])

    y = lax.map(expert_block, (rows, block_expert)).reshape(-1, D)
    contrib = y[dest].astype(jnp.float32) * sorted_w[:, None]
    return jax.ops.segment_sum(contrib, sorted_tok, num_segments=T).astype(h.dtype)


def setup_inputs(seed: int = 0) -> dict:
    key = jax.random.key(seed)
    ks = iter(jax.random.split(key, 32))
    D, dh = D_MODEL, HEAD_DIM

    def nrm(shape, scale):
        return jax.random.normal(next(ks), shape, jnp.float32) * scale

    def gain(shape):
        return 1.0 + nrm(shape, 0.02)

    return {
        "x": nrm((BATCH, SEQ, D), 1.0),
        "c": nrm((BATCH, D), 1.0),
        "rel_table": nrm((REL_BUCKETS, N_HEADS_NSA), 0.2),
        "w_ada": nrm((DEPTH, D, 6 * D), 0.5 * D ** -0.5),
        "b_ada": nrm((DEPTH, 6 * D), 0.01),
        "g_pre_mix": gain((DEPTH, D)),
        "g_post_mix": gain((DEPTH, D)),
        "g_pre_ffn": gain((DEPTH, D)),
        "g_post_ffn": gain((DEPTH, D)),
        "w_in": nrm((DEPTH, D, IN_COLS), D ** -0.5),
        "w_out": nrm((DEPTH, W_SB + W_NSA, D), (W_SB + W_NSA) ** -0.5),
        "g_sb": gain((DEPTH, W_SB)),
        "g_nsa": gain((DEPTH, W_NSA)),
        "cmp_pos_k": nrm((DEPTH, CMP_BLOCK, dh), 0.5),
        "cmp_w1_k": nrm((DEPTH, CMP_BLOCK * dh, CMP_HIDDEN), (CMP_BLOCK * dh) ** -0.5),
        "cmp_w2_k": nrm((DEPTH, CMP_HIDDEN, dh), CMP_HIDDEN ** -0.5),
        "cmp_pos_v": nrm((DEPTH, CMP_BLOCK, dh), 0.5),
        "cmp_w1_v": nrm((DEPTH, CMP_BLOCK * dh, CMP_HIDDEN), (CMP_BLOCK * dh) ** -0.5),
        "cmp_w2_v": nrm((DEPTH, CMP_HIDDEN, dh), CMP_HIDDEN ** -0.5),
        "ffn_w_gate": nrm((N_DENSE_LAYERS, D, D_FF_DENSE), D ** -0.5),
        "ffn_w_up": nrm((N_DENSE_LAYERS, D, D_FF_DENSE), D ** -0.5),
        "ffn_w_down": nrm((N_DENSE_LAYERS, D_FF_DENSE, D), D_FF_DENSE ** -0.5),
        "moe_w_router": nrm((N_MOE_LAYERS, D, N_EXPERTS), D ** -0.5),
        "moe_b_router": nrm((N_MOE_LAYERS, N_EXPERTS), 0.01),
        "moe_w_gate": nrm((N_MOE_LAYERS, N_EXPERTS, D, D_FF_EXPERT), D ** -0.5),
        "moe_w_up": nrm((N_MOE_LAYERS, N_EXPERTS, D, D_FF_EXPERT), D ** -0.5),
        "moe_w_down": nrm((N_MOE_LAYERS, N_EXPERTS, D_FF_EXPERT, D), D_FF_EXPERT ** -0.5),
    }


def reference(x, c, rel_table, w_ada, b_ada, g_pre_mix, g_post_mix, g_pre_ffn, g_post_ffn,
              w_in, w_out, g_sb, g_nsa, cmp_pos_k, cmp_w1_k, cmp_w2_k, cmp_pos_v, cmp_w1_v,
              cmp_w2_v, ffn_w_gate, ffn_w_up, ffn_w_down, moe_w_router, moe_b_router,
              moe_w_gate, moe_w_up, moe_w_down):
    B, S, D = x.shape
    c_act = jax.nn.silu(c)
    for layer in range(DEPTH):
        mod = (c_act @ w_ada[layer] + b_ada[layer])[:, None, :]
        shift_m, scale_m, gate_m, shift_f, scale_f, gate_f = jnp.split(mod, 6, axis=-1)

        h = rms_norm(x, g_pre_mix[layer]) * (1.0 + scale_m) + shift_m
        m = hybrid_mixer(h, w_in[layer], w_out[layer], g_sb[layer], g_nsa[layer], rel_table,
                         cmp_pos_k[layer], cmp_w1_k[layer], cmp_w2_k[layer],
                         cmp_pos_v[layer], cmp_w1_v[layer], cmp_w2_v[layer])
        x = x + gate_m * rms_norm(m, g_post_mix[layer])

        h = rms_norm(x, g_pre_ffn[layer]) * (1.0 + scale_f) + shift_f
        i = layer // 2
        if layer % 2 == 0:
            f = swiglu(h, ffn_w_gate[i], ffn_w_up[i], ffn_w_down[i])
        else:
            f = moe_swiglu(h.reshape(B * S, D), moe_w_router[i], moe_b_router[i],
                           moe_w_gate[i], moe_w_up[i], moe_w_down[i]).reshape(B, S, D)
        x = x + gate_f * rms_norm(f, g_post_ffn[layer])
    return x
```

```cpp
#include <hip/hip_runtime.h>
#include <cstdint>
#include <cstdio>

#define GAS __attribute__((address_space(1)))
#define LAS __attribute__((address_space(3)))
typedef unsigned short bf16;
typedef short bf16x8 __attribute__((ext_vector_type(8)));
typedef float f32x4 __attribute__((ext_vector_type(4)));
typedef unsigned u32x4 __attribute__((ext_vector_type(4)));
typedef unsigned u32x2 __attribute__((ext_vector_type(2)));
typedef __bf16 bf16x2_t __attribute__((ext_vector_type(2)));

#ifndef MK_SINGLE
#define MK_SINGLE 1
#endif

constexpr int NB = 2, SEQ = 8192, T = NB * SEQ, DM = 1024, DH = 64;
constexpr int IN_COLS = 2840, NPROJ = 3072;
constexpr int NCMP = 511;
constexpr int DFF = 2816, DFE = 3584, NE = 8;
constexpr int MOE_ROWS = 34816;
constexpr float EPS = 1e-6f;
constexpr int NWAVES = 8, NTHR = 512;

constexpr size_t MiB = 1u << 20;
constexpr size_t WS_CTL = 0, CTL_ZERO_BYTES = 65536;
constexpr size_t WS_WIN = 1 * MiB;
constexpr size_t WS_WOUT = 13 * MiB;
constexpr size_t WS_CW1 = 17 * MiB;
constexpr size_t WS_CW2 = 21 * MiB;
constexpr size_t WS_CBIAS = 21 * MiB + 131072;
constexpr size_t WS_MOD = 524288;
constexpr size_t WS_FGU = 22 * MiB;
constexpr size_t WS_FD = 33 * MiB;
constexpr size_t WS_MGU = 39 * MiB;
constexpr size_t WS_MD = 151 * MiB;
constexpr size_t WS_H = 207 * MiB;
constexpr size_t WS_AR = 239 * MiB;
constexpr size_t AR_SBQ = WS_AR, AR_SBK = WS_AR + 16 * MiB, AR_SBV = WS_AR + 32 * MiB, AR_NQ = WS_AR + 48 * MiB, AR_NKV = WS_AR + 64 * MiB;
constexpr size_t AR_GATES = WS_AR + 88 * MiB, AR_KC = WS_AR + 90 * MiB, AR_ORAW = WS_AR + 92 * MiB, AR_OWIN = WS_AR + 156 * MiB;
constexpr size_t AR_CHID = WS_AR + 188 * MiB;
constexpr size_t AR_M = WS_AR;
constexpr size_t AR_FHID = WS_AR + 64 * MiB, AR_FOUT = WS_AR + 152 * MiB;
constexpr size_t AR_HIDM = WS_AR, AR_TOKINFO = WS_AR + 240 * MiB, AR_ROWTOK = WS_AR + 241 * MiB;
constexpr size_t WS_Y = 1 * MiB;
constexpr size_t WS_END = WS_AR + 242 * MiB;
constexpr size_t WS_YPART = 72 * MiB;
static_assert(WS_Y + (size_t)MOE_ROWS * 1024 * 4 <= WS_MD, "y overlay");
static_assert(WS_Y + (size_t)MOE_ROWS * 1024 * 2 <= WS_YPART && WS_YPART + (size_t)7 * 2048 * 1024 * 2 <= WS_MD, "y partials overlay");
static_assert(AR_HIDM + (size_t)MOE_ROWS * DFE * 2 <= AR_TOKINFO, "moe hidden");

constexpr int CW_BAR = 4096, CW_CNT = 8192, CW_QUEUE = 8448;

constexpr int RING_OFF = 0, RING_BYTES = 131072;
constexpr int LDSCTL_OFF = RING_BYTES;
constexpr int BIASL_OFF = LDSCTL_OFF + 1536;
constexpr int LDS_BYTES = 147456;

struct Args { const float* in[27]; float* out; unsigned char* ws; int ph_lo, ph_hi; };

typedef float f32x2_t __attribute__((ext_vector_type(2)));
__device__ __forceinline__ unsigned cvt_pk_bf16(float lo, float hi) { const f32x2_t v = {lo, hi}; const bf16x2_t b = __builtin_convertvector(v, bf16x2_t); return __builtin_bit_cast(unsigned, b); }
__device__ __forceinline__ float wave_sum(float v) {
    v += __uint_as_float(__builtin_amdgcn_update_dpp(0, __float_as_uint(v), 0xB1, 0xf, 0xf, true));
    v += __uint_as_float(__builtin_amdgcn_update_dpp(0, __float_as_uint(v), 0x4E, 0xf, 0xf, true));
    v += __uint_as_float(__builtin_amdgcn_update_dpp(0, __float_as_uint(v), 0x141, 0xf, 0xf, true));
    v += __uint_as_float(__builtin_amdgcn_update_dpp(0, __float_as_uint(v), 0x140, 0xf, 0xf, true));
    auto a = __builtin_amdgcn_permlane16_swap(__float_as_uint(v), __float_as_uint(v), false, false); v = __uint_as_float(a[0]) + __uint_as_float(a[1]);
    auto b = __builtin_amdgcn_permlane32_swap(__float_as_uint(v), __float_as_uint(v), false, false); return __uint_as_float(b[0]) + __uint_as_float(b[1]);
}


__host__ __device__ __forceinline__ size_t koff(int s, int d) { return (size_t)(s >> 4) * 1024 + (size_t)((d >> 5) * 512 + ((d >> 3) & 3) * 128 + (s & 15) * 8 + (d & 7)); }
__host__ __device__ __forceinline__ size_t voff(int s, int d) { return (size_t)(s >> 5) * 2048 + (size_t)((d >> 4) * 512 + ((s & 15) >> 2) * 128 + (d & 15) * 8 + ((s >> 4) & 1) * 4 + (s & 3)); }

__host__ __device__ __forceinline__ size_t k8off(int s, int d) { return (size_t)(s >> 4) * 1024 + (size_t)(((d >> 3) & 3) * 256 + (s & 15) * 16 + (d >> 5) * 8 + (d & 7)); }
__host__ __device__ __forceinline__ size_t v8off(int s, int d) { return (size_t)(s >> 5) * 2048 + (size_t)((d >> 5) * 1024 + ((s & 15) >> 2) * 256 + (d & 15) * 16 + ((d >> 4) & 1) * 8 + ((s >> 4) & 1) * 4 + (s & 3)); }
__device__ __forceinline__ unsigned cvt4_fp8(float a, float b, float c, float d) { int w = __builtin_amdgcn_cvt_pk_fp8_f32(a, b, 0, false); w = __builtin_amdgcn_cvt_pk_fp8_f32(c, d, w, true); return (unsigned)w; }

namespace pg8 {
constexpr int BM = 256, BK = 64, HALF = 128, HTB = HALF * BK * 2, NXCD = 8, WGM = 8;
__host__ __device__ __forceinline__ int lds_byte(int r, int c) { const int st = (r >> 4) * 2 + (c >> 5), rr = r & 15, cc = c & 31, ob = rr * 64 + cc * 2; return st * 1024 + (ob ^ (((ob >> 9) & 1) << 5)); }
__host__ __device__ __forceinline__ void stage_rc(int b, int& R, int& C) { const int st = b / 1024, sb = b % 1024, swz = sb ^ (((sb >> 9) & 1) << 5); R = (st >> 1) * 16 + swz / 64; C = (st & 1) * 32 + (swz % 64) / 2; }
__host__ __device__ __forceinline__ int perm32(int rho) { const int n = rho >> 4, i = rho & 15; return 8 * (i >> 2) + 4 * n + (i & 3); }
struct Unit { int pm, pn, ga, gl, k0, nt, part; };
struct Gemm { const bf16* A; const bf16* Bt; int M, N, K; };
struct StaticOrder {
    static constexpr bool SPLIT = false;
    int nM, nN, nwg, G, c;
    __device__ void init(int M, int N, int G_, int c_) { nM = M / BM; nN = N / BM; nwg = nM * nN; G = G_; c = c_; }
    __device__ bool next(int i, Unit& u) const {
        const long L = (long)i * G + c; if (L >= nwg) return false;
        int wgid = (int)L; { const int q = nwg / NXCD, r = nwg % NXCD, xcd = wgid % NXCD, off = wgid / NXCD; wgid = (xcd < r ? xcd * (q + 1) : r * (q + 1) + (xcd - r) * q) + off; }
        const int nig = WGM * nN, gid = wgid / nig, fm = gid * WGM, gsz = (nM - fm) < WGM ? (nM - fm) : WGM;
        u.pm = fm + ((wgid % nig) % gsz); u.pn = (wgid % nig) / gsz; u.ga = 0; u.gl = 0; return true;
    }
};
struct MoeOrder {
    static constexpr bool SPLIT = false;
    int nt0, nt1, nt2, nt3, nt4, nt5, nt6, nt7; int nN, G, c; int cn0, cn1, cn2, cn3, cn4, cn5, cn6, cn7;
    __device__ bool next(int i, Unit& u) const {
        int L = i * G + c; int tb = 0; bool found = false;
#define MOE_STEP(e, nte) if (!found) { const int ue = nte * nN; if (L < ue) { u.pm = tb + L % nte; u.pn = e * nN + L / nte; u.ga = e * 16384 - tb * 256; u.gl = tb * 256 + cn##e; found = true; } else { L -= ue; tb += nte; } }
        MOE_STEP(0, nt0) MOE_STEP(1, nt1) MOE_STEP(2, nt2) MOE_STEP(3, nt3) MOE_STEP(4, nt4) MOE_STEP(5, nt5) MOE_STEP(6, nt6) MOE_STEP(7, nt7)
#undef MOE_STEP
        return found;
    }
};

struct MoeDownOrder {
    static constexpr bool SPLIT = true;
    int nt0, nt1, nt2, nt3, nt4, nt5, nt6, nt7; int nN, G, c, nfull, S, ntk;
    __device__ bool next(int i, Unit& u) const {
        int L = i * G + c; int tb = 0; bool found = false;
#define MOE_STEP(e, nte) if (!found) { int fe = nfull - tb; fe = fe < 0 ? 0 : (fe > nte ? nte : fe); const int ue = fe * nN; if (L < ue) { u.pm = tb + L % fe; u.pn = e * nN + L / fe; found = true; } else { L -= ue; tb += nte; } }
        MOE_STEP(0, nt0) MOE_STEP(1, nt1) MOE_STEP(2, nt2) MOE_STEP(3, nt3) MOE_STEP(4, nt4) MOE_STEP(5, nt5) MOE_STEP(6, nt6) MOE_STEP(7, nt7)
#undef MOE_STEP
        u.ga = 0; u.gl = 0; u.k0 = 0; u.nt = ntk; u.part = -1;
        if (found) return true;
        const int ntail = tb - nfull;
        if (S <= 1 || L >= ntail * nN * S) return false;
        const int s = L % S, j = L / S, tile = nfull + j % ntail, pnl = j / ntail;
        int e = 0, te = nt0;
#define MOE_FIND(nte) if (tile >= te) { ++e; te += nte; }
        MOE_FIND(nt1) MOE_FIND(nt2) MOE_FIND(nt3) MOE_FIND(nt4) MOE_FIND(nt5) MOE_FIND(nt6) MOE_FIND(nt7)
#undef MOE_FIND
        u.pm = tile; u.pn = e * nN + pnl; u.nt = ntk / S; u.k0 = s * (ntk / S) * (BK * 2); u.part = s;
        return true;
    }
};

template <class Epi, class Sched, bool ALIGN_EPI, int GATHER>
__device__ __forceinline__ void gemm_phase(LAS unsigned char* lds, const Gemm g, const int* rowidx, const Sched& S, const Epi& E) {
    const int tid = threadIdx.x, wid = __builtin_amdgcn_readfirstlane(tid >> 6), lane = tid & 63, wr = wid >> 2, wc = wid & 3, fr = lane & 15, fq = lane >> 4;
    const int K = g.K, nt = K / BK;
    int RA[2]; unsigned CA2[2], voffB[2];
#pragma unroll
    for (int i = 0; i < 2; ++i) { int R, C; stage_rc(tid * 16 + i * 8192, R, C); const int Rb = (R & ~31) + perm32(R & 31);
        RA[i] = R; CA2[i] = (unsigned)C * 2u; voffB[i] = (unsigned)(Rb * K + C) * 2u; }
    const unsigned rowbytes = GATHER == 2 ? 2048u : (unsigned)K * 2u;
    const size_t kstep = (size_t)(BK * 2);
    const size_t hstep = (size_t)HALF * K * 2;
    const size_t tstep = 2 * hstep;
    const unsigned ldsw = (unsigned)wid * 1024u;
    const int aoff = lds_byte(wr * 64 + fr, fq * 8), boff = lds_byte(wc * 32 + fr, fq * 8);
    const char* Abase = (const char*)g.A;
#define PG8_SA(b, h) (((b) * 2 + (h)) * HTB)
#define PG8_SB(b, h) ((4 + (b) * 2 + (h)) * HTB)
#define PG8_STAGE_B(bufoff, gbase) do { _Pragma("unroll") for (int _i = 0; _i < 2; ++_i) \
        __builtin_amdgcn_global_load_lds((const unsigned*)((const char*)(gbase) + voffB[_i]), (LAS unsigned*)(lds + (bufoff) + ldsw + _i * 8192), 16, 0, 0); } while (0)
#define PG8_STAGE_A(bufoff, GG, h, kb) do { _Pragma("unroll") for (int _i = 0; _i < 2; ++_i) \
        __builtin_amdgcn_global_load_lds((const unsigned*)(Abase + (size_t)(kb) + (size_t)GG[h][_i]), (LAS unsigned*)(lds + (bufoff) + ldsw + _i * 8192), 16, 0, 0); } while (0)
#define PG8_CALC_G(U_, GG) do { _Pragma("unroll") for (int _h = 0; _h < 2; ++_h) _Pragma("unroll") for (int _i = 0; _i < 2; ++_i) { \
        int _row = (U_).pm * BM + _h * HALF + RA[_i]; if (GATHER == 1) _row = _row < (U_).gl ? rowidx[_row + (U_).ga] : 0; if (GATHER == 2) { const int _n = _row & 511; _row = (_row & ~511) | (_n > 510 ? 510 : _n); } GG[_h][_i] = (unsigned)_row * rowbytes + CA2[_i] + (Sched::SPLIT ? (unsigned)(U_).k0 : 0u); } } while (0)
#define PG8_LDA(dst, b, h) do { _Pragma("unroll") for (int m = 0; m < 4; ++m) _Pragma("unroll") for (int k = 0; k < 2; ++k) dst[m][k] = *(const LAS bf16x8*)(lds + PG8_SA(b, h) + aoff + m * 2048 + k * 1024); } while (0)
#define PG8_LDB(dst, b, h) do { _Pragma("unroll") for (int n = 0; n < 2; ++n) _Pragma("unroll") for (int k = 0; k < 2; ++k) dst[n][k] = *(const LAS bf16x8*)(lds + PG8_SB(b, h) + boff + n * 2048 + k * 1024); } while (0)
#define PG8_MMA(ai, bj, At, Bt) do { __builtin_amdgcn_s_setprio(1); _Pragma("unroll") for (int m = 0; m < 4; ++m) _Pragma("unroll") for (int n = 0; n < 2; ++n) _Pragma("unroll") for (int k = 0; k < 2; ++k) \
        acc[ai][bj][m][n] = __builtin_amdgcn_mfma_f32_16x16x32_bf16(Bt[n][k], At[m][k], acc[ai][bj][m][n], 0, 0, 0); __builtin_amdgcn_s_setprio(0); } while (0)
#define PG8_WAIT_V(n) asm volatile("s_waitcnt vmcnt(" #n ")" ::: "memory")
#define PG8_WAIT_L(n) asm volatile("s_waitcnt lgkmcnt(" #n ")" ::: "memory")
#define PG8_BAR __builtin_amdgcn_s_barrier()
#define PG8_SCHED __builtin_amdgcn_sched_barrier(0)
    Unit cur, nxt; int ui = 0;
    if (!S.next(0, cur)) return;
    f32x4 acc[2][2][4][2];
#pragma unroll
    for (int a = 0; a < 2; ++a)
#pragma unroll
        for (int b = 0; b < 2; ++b)
#pragma unroll
            for (int m = 0; m < 4; ++m)
#pragma unroll
                for (int n = 0; n < 2; ++n) acc[a][b][m][n] = (f32x4){0.f, 0.f, 0.f, 0.f};
    bf16x8 At[4][2], B0[2][2], B1[2][2];
    unsigned gc[2][2], gn[2][2];
    PG8_CALC_G(cur, gc);
    const char* cB = (const char*)g.Bt + (size_t)cur.pn * tstep + (Sched::SPLIT ? (size_t)cur.k0 : (size_t)0);
    PG8_STAGE_B(PG8_SB(0, 0), cB); PG8_STAGE_B(PG8_SB(0, 1), cB + hstep); PG8_STAGE_A(PG8_SA(0, 0), gc, 0, 0); PG8_STAGE_A(PG8_SA(0, 1), gc, 1, 0);
    if (wr == 1) PG8_BAR;
    PG8_WAIT_V(2); PG8_BAR;
    PG8_STAGE_B(PG8_SB(1, 0), cB + kstep); PG8_STAGE_A(PG8_SA(1, 0), gc, 0, kstep); PG8_STAGE_B(PG8_SB(1, 1), cB + hstep + kstep);
    PG8_WAIT_V(6); PG8_BAR;
    for (;;) {
        const bool has_next = S.next(ui + 1, nxt);
        if (has_next) { PG8_CALC_G(nxt, gn); }
        else {
#pragma unroll
            for (int h = 0; h < 2; ++h)
#pragma unroll
                for (int i = 0; i < 2; ++i) gn[h][i] = gc[h][i];
        }
        const char* nB = has_next ? (const char*)g.Bt + (size_t)nxt.pn * tstep + (Sched::SPLIT ? (size_t)nxt.k0 : (size_t)0) : cB;
        const int cnt = Sched::SPLIT ? cur.nt : nt;
        for (int t = 0; t < cnt; t += 2) {
            const bool last = (t == cnt - 2);
            const size_t kb1 = (size_t)(t + 1) * kstep;
            unsigned g2[2][2];
#pragma unroll
            for (int h = 0; h < 2; ++h)
#pragma unroll
                for (int i = 0; i < 2; ++i) g2[h][i] = last ? gn[h][i] : gc[h][i];
            const size_t kb2 = last ? (size_t)0 : (size_t)(t + 2) * kstep, kb3 = kb2 + kstep;
            const char* b2 = last ? nB : cB + (size_t)(t + 2) * kstep; const char* b3 = b2 + kstep;
            PG8_LDB(B0, 0, 0); PG8_LDB(B1, 0, 1); PG8_SCHED; PG8_LDA(At, 0, 0); PG8_STAGE_A(PG8_SA(1, 1), gc, 1, kb1);
            PG8_WAIT_V(8); PG8_WAIT_L(0); PG8_BAR; PG8_MMA(0, 0, At, B0); PG8_MMA(0, 1, At, B1); PG8_BAR; PG8_SCHED;
            PG8_LDA(At, 0, 1); PG8_STAGE_B(PG8_SB(0, 0), b2); PG8_STAGE_B(PG8_SB(0, 1), b2 + hstep); PG8_STAGE_A(PG8_SA(0, 0), g2, 0, kb2);
            PG8_WAIT_V(8); PG8_WAIT_L(0); PG8_BAR; PG8_MMA(1, 0, At, B0); PG8_MMA(1, 1, At, B1); PG8_BAR; PG8_SCHED;
            PG8_LDB(B0, 1, 0); PG8_LDB(B1, 1, 1); PG8_SCHED; PG8_LDA(At, 1, 0); PG8_STAGE_A(PG8_SA(0, 1), g2, 1, kb2);
            PG8_WAIT_V(8); PG8_WAIT_L(0); PG8_BAR; PG8_MMA(0, 0, At, B0); PG8_MMA(0, 1, At, B1); PG8_BAR; PG8_SCHED;
            PG8_LDA(At, 1, 1); PG8_STAGE_B(PG8_SB(1, 0), b3); PG8_STAGE_B(PG8_SB(1, 1), b3 + hstep); PG8_STAGE_A(PG8_SA(1, 0), g2, 0, kb3);
            PG8_WAIT_V(8); PG8_WAIT_L(0); PG8_BAR; PG8_MMA(1, 0, At, B0); PG8_MMA(1, 1, At, B1); PG8_BAR; PG8_SCHED;
        }
        if constexpr (ALIGN_EPI) { if (wr == 0) PG8_BAR; }
        E(acc, cur, wr, wc, fr, fq);
        if (!has_next) break;
#pragma unroll
        for (int a = 0; a < 2; ++a)
#pragma unroll
            for (int b = 0; b < 2; ++b)
#pragma unroll
                for (int m = 0; m < 4; ++m)
#pragma unroll
                    for (int n = 0; n < 2; ++n) acc[a][b][m][n] = (f32x4){0.f, 0.f, 0.f, 0.f};
        cur = nxt; cB = nB; ++ui;
#pragma unroll
        for (int h = 0; h < 2; ++h)
#pragma unroll
            for (int i = 0; i < 2; ++i) gc[h][i] = gn[h][i];
        if constexpr (ALIGN_EPI) { if (wr == 1) PG8_BAR; }
    }
    PG8_WAIT_V(0);
    if constexpr (!ALIGN_EPI) { if (wr == 0) PG8_BAR; }
    PG8_BAR;
#undef PG8_SA
#undef PG8_SB
#undef PG8_STAGE_A
#undef PG8_STAGE_B
#undef PG8_CALC_G
#undef PG8_LDA
#undef PG8_LDB
#undef PG8_MMA
#undef PG8_WAIT_V
#undef PG8_WAIT_L
#undef PG8_BAR
#undef PG8_SCHED
}

struct EpiProj {
    bf16* base; float* gates;
    __device__ __forceinline__ void operator()(const f32x4 (&acc)[2][2][4][2], const Unit& u, int wr, int wc, int fr, int fq) const {
#pragma unroll
        for (int ai = 0; ai < 2; ++ai)
#pragma unroll
            for (int m = 0; m < 4; ++m) {
                const int row = u.pm * BM + ai * HALF + wr * 64 + m * 16 + fr, b = row >> 13, s = row & 8191;
#pragma unroll
                for (int bj = 0; bj < 2; ++bj) {
                    const int c = u.pn * BM + bj * HALF + wc * 32 + 8 * fq;
                    const f32x4 v0 = acc[ai][bj][m][0], v1 = acc[ai][bj][m][1];
                    if (c < 2816) {
                        size_t tb_; int mode_ = 0; const int d = c & 63;
                        if (c < 2048) { const int region = c >> 9, h = (c & 511) >> 6; tb_ = (size_t)region * 8388608u + (size_t)(b * 8 + h) * SEQ * 64; mode_ = region == 1 ? 1 : (region == 2 ? 2 : 0); }
                        else { const int idx = c - 2048, br = idx >> 8, kv = (idx >> 7) & 1, gg = (idx >> 6) & 1;
                            tb_ = (size_t)4 * 8388608u + (size_t)(((br * 2 + kv) * 2 + b) * 2 + gg) * SEQ * 64; mode_ = br == 0 ? 0 : (kv == 0 ? 1 : 2); if (br == 1) mode_ += 2; }
                        u32x4 w; w.x = cvt_pk_bf16(v0[0], v0[1]); w.y = cvt_pk_bf16(v0[2], v0[3]); w.z = cvt_pk_bf16(v1[0], v1[1]); w.w = cvt_pk_bf16(v1[2], v1[3]);
                        if (mode_ >= 3) {
                            unsigned char* bp = (unsigned char*)(base + tb_);
                            const unsigned f0 = cvt4_fp8(v0[0], v0[1], v0[2], v0[3]), f1 = cvt4_fp8(v1[0], v1[1], v1[2], v1[3]);
                            if (mode_ == 3) { u32x2 q; q.x = f0; q.y = f1; *(u32x2*)(bp + k8off(s, d)) = q; }
                            else { unsigned char* tp = bp + v8off(s, d);
                                tp[0] = (unsigned char)f0; tp[16] = (unsigned char)(f0 >> 8); tp[32] = (unsigned char)(f0 >> 16); tp[48] = (unsigned char)(f0 >> 24);
                                tp[64] = (unsigned char)f1; tp[80] = (unsigned char)(f1 >> 8); tp[96] = (unsigned char)(f1 >> 16); tp[112] = (unsigned char)(f1 >> 24); }
                        } else if (mode_ == 2) {
                            bf16* tp = base + tb_ + voff(s, d);
                            tp[0] = (bf16)(w.x & 0xffffu); tp[8] = (bf16)(w.x >> 16); tp[16] = (bf16)(w.y & 0xffffu); tp[24] = (bf16)(w.y >> 16);
                            tp[32] = (bf16)(w.z & 0xffffu); tp[40] = (bf16)(w.z >> 16); tp[48] = (bf16)(w.w & 0xffffu); tp[56] = (bf16)(w.w >> 16);
                        } else *(u32x4*)(base + tb_ + (mode_ == 1 ? koff(s, d) : (size_t)s * 64 + d)) = w;
                    } else if (c < IN_COLS) {
                        float* gp = gates + (size_t)row * 24 + (c - 2816);
                        f32x4 a, bb;
                        a.x = 1.f / (1.f + __expf(-v0.x)); a.y = 1.f / (1.f + __expf(-v0.y)); a.z = 1.f / (1.f + __expf(-v0.z)); a.w = 1.f / (1.f + __expf(-v0.w));
                        bb.x = 1.f / (1.f + __expf(-v1.x)); bb.y = 1.f / (1.f + __expf(-v1.y)); bb.z = 1.f / (1.f + __expf(-v1.z)); bb.w = 1.f / (1.f + __expf(-v1.w));
                        *(f32x4*)gp = a; *(f32x4*)(gp + 4) = bb;
                    }
                }
            }
    }
};
struct EpiOutBf16 {
    bf16* O; int ldc;
    __device__ __forceinline__ void operator()(const f32x4 (&acc)[2][2][4][2], const Unit& u, int wr, int wc, int fr, int fq) const {
#pragma unroll
        for (int ai = 0; ai < 2; ++ai)
#pragma unroll
            for (int m = 0; m < 4; ++m) {
                const int row = u.pm * BM + ai * HALF + wr * 64 + m * 16 + fr;
#pragma unroll
                for (int bj = 0; bj < 2; ++bj) {
                    bf16* p = O + (size_t)row * ldc + (u.pn % (ldc / BM)) * BM + bj * HALF + wc * 32 + 8 * fq;
                    const f32x4 v0 = acc[ai][bj][m][0], v1 = acc[ai][bj][m][1];
                    u32x4 w; w.x = cvt_pk_bf16(v0[0], v0[1]); w.y = cvt_pk_bf16(v0[2], v0[3]); w.z = cvt_pk_bf16(v1[0], v1[1]); w.w = cvt_pk_bf16(v1[2], v1[3]);
                    *(u32x4*)p = w;
                }
            }
    }
};
struct EpiMoeDown {
    bf16* O; bf16* P; int row0;
    __device__ __forceinline__ void operator()(const f32x4 (&acc)[2][2][4][2], const Unit& u, int wr, int wc, int fr, int fq) const {
        bf16* Ob = u.part < 0 ? O : P + ((ptrdiff_t)u.part * 2048 - row0) * 1024;
#pragma unroll
        for (int ai = 0; ai < 2; ++ai)
#pragma unroll
            for (int m = 0; m < 4; ++m) {
                const int row = u.pm * BM + ai * HALF + wr * 64 + m * 16 + fr;
#pragma unroll
                for (int bj = 0; bj < 2; ++bj) {
                    bf16* p = Ob + (ptrdiff_t)row * 1024 + (u.pn & 3) * BM + bj * HALF + wc * 32 + 8 * fq;
                    const f32x4 v0 = acc[ai][bj][m][0], v1 = acc[ai][bj][m][1];
                    u32x4 w; w.x = cvt_pk_bf16(v0[0], v0[1]); w.y = cvt_pk_bf16(v0[2], v0[3]); w.z = cvt_pk_bf16(v1[0], v1[1]); w.w = cvt_pk_bf16(v1[2], v1[3]);
                    *(u32x4*)p = w;
                }
            }
    }
};
struct EpiSwiglu {
    bf16* Hd; int ldh; int nNper;
    __device__ __forceinline__ void operator()(const f32x4 (&acc)[2][2][4][2], const Unit& u, int wr, int wc, int fr, int fq) const {
        const int pnl = u.pn % nNper;
#pragma unroll
        for (int ai = 0; ai < 2; ++ai)
#pragma unroll
            for (int m = 0; m < 4; ++m) {
                const int row = u.pm * BM + ai * HALF + wr * 64 + m * 16 + fr;
                float h[8];
#pragma unroll
                for (int n = 0; n < 2; ++n)
#pragma unroll
                    for (int j = 0; j < 4; ++j) { const float gt = acc[ai][0][m][n][j], up = acc[ai][1][m][n][j]; h[n * 4 + j] = gt * __builtin_amdgcn_rcpf(1.f + __builtin_amdgcn_exp2f(gt * -1.4426950408889634f)) * up; }
                u32x4 w; w.x = cvt_pk_bf16(h[0], h[1]); w.y = cvt_pk_bf16(h[2], h[3]); w.z = cvt_pk_bf16(h[4], h[5]); w.w = cvt_pk_bf16(h[6], h[7]);
                *(u32x4*)(Hd + (size_t)row * ldh + pnl * HALF + wc * 32 + 8 * fq) = w;
            }
    }
};

struct CmpOrder { static constexpr bool SPLIT = false; int G, c;
    __device__ bool next(int i, Unit& u) const { const int L = i * G + c; if (L >= 16) return false; u.pm = L; u.pn = L >> 3; u.ga = 0; u.gl = 0; return true; } };
__device__ __forceinline__ float gelu_tanh_pg(float x) { const float uu = 0.7978845608028654f * (x + 0.044715f * x * x * x); const float t = 1.f - 2.f / (__expf(2.f * uu) + 1.f); return 0.5f * x * (1.f + t); }
struct EpiCmpHid {
    bf16* Hd; const float* bias;
    __device__ __forceinline__ void operator()(const f32x4 (&acc)[2][2][4][2], const Unit& u, int wr, int wc, int fr, int fq) const {
        const float* bp = bias + u.pn * 256;
#pragma unroll
        for (int ai = 0; ai < 2; ++ai)
#pragma unroll
            for (int m = 0; m < 4; ++m) {
                const int row = u.pm * BM + ai * HALF + wr * 64 + m * 16 + fr;
#pragma unroll
                for (int bj = 0; bj < 2; ++bj) {
                    const int col = bj * HALF + wc * 32 + 8 * fq;
                    const f32x4 b0 = *(const f32x4*)(bp + col), b1 = *(const f32x4*)(bp + col + 4);
                    float h[8];
#pragma unroll
                    for (int j = 0; j < 4; ++j) { h[j] = gelu_tanh_pg(acc[ai][bj][m][0][j] + b0[j]); h[4 + j] = gelu_tanh_pg(acc[ai][bj][m][1][j] + b1[j]); }
                    u32x4 w; w.x = cvt_pk_bf16(h[0], h[1]); w.y = cvt_pk_bf16(h[2], h[3]); w.z = cvt_pk_bf16(h[4], h[5]); w.w = cvt_pk_bf16(h[6], h[7]);
                    *(u32x4*)(Hd + (size_t)row * 256 + col) = w;
                }
            }
    }
};
}

#define XB_TMO      128
#define XB_XCNT(j)  (256  + 64 * (j))
#define XB_XSUB(j)  (1280 + 64 * (j))
#define XB_XGEN(j)  (2304 + 64 * (j))
#define XB_TOP      3328
#define XB_TOPGEN   3392
#define XCD_BAR_WORDS 3456
#define XB_SPIN_CAP (1u << 18)
__device__ __forceinline__ unsigned xb_ld(unsigned* p)              { return __hip_atomic_load(p, __ATOMIC_RELAXED, __HIP_MEMORY_SCOPE_AGENT); }
__device__ __forceinline__ unsigned xb_add(unsigned* p, unsigned v) { return __hip_atomic_fetch_add(p, v, __ATOMIC_RELAXED, __HIP_MEMORY_SCOPE_AGENT); }
__device__ __forceinline__ unsigned xb_xcc_id() { return (unsigned)__builtin_amdgcn_s_getreg((3 << 11) | 20) & 0xFu; }
#define XB_SPIN(cond, bar) do { unsigned _sp = 0; while (cond) { __builtin_amdgcn_s_sleep(1); \
    if ((++_sp & 255u) == 0u) { if (xb_ld(&(bar)[XB_TMO])) break; if (_sp > XB_SPIN_CAP) { atomicAdd(&(bar)[XB_TMO], 1u); break; } } } } while (0)
struct XcdBarrier { unsigned* bar; unsigned x; volatile LAS unsigned* st; };
__device__ __forceinline__ XcdBarrier xcd_barrier_post(unsigned* bar, volatile LAS unsigned* st) {
    XcdBarrier b; b.bar = bar; b.x = xb_xcc_id(); b.st = st;
    if (threadIdx.x == 0) (void)xb_add(&bar[XB_XCNT(b.x)], 1u);
    return b;
}
__device__ __forceinline__ void xcd_barrier_complete(unsigned* bar, unsigned x, unsigned& nloc, unsigned& nx) {
    const unsigned G = gridDim.x * gridDim.y * gridDim.z;
    unsigned sum, cnt, mine, sp = 0u;
    for (;;) {
        sum = 0u; cnt = 0u; mine = 0u;
#pragma unroll
        for (unsigned j = 0; j < 16; ++j) { const unsigned c = xb_ld(&bar[XB_XCNT(j)]); sum += c; cnt += (c > 0u) ? 1u : 0u; mine = (j == x) ? c : mine; }
        if (sum == G) break;
        __builtin_amdgcn_s_sleep(1);
        if ((++sp & 255u) == 0u) { if (xb_ld(&bar[XB_TMO])) break; if (sp > XB_SPIN_CAP) { atomicAdd(&bar[XB_TMO], 1u); break; } }
    }
    nloc = mine > 0u ? mine : 1u; nx = cnt > 0u ? cnt : 1u;
}
__device__ __forceinline__ void xcd_barrier(const XcdBarrier& b) {
    asm volatile("s_waitcnt vmcnt(0)" ::: "memory");
    __syncthreads();
    if (threadIdx.x == 0) {
        unsigned* bar = b.bar;
        __builtin_amdgcn_s_waitcnt(0);
        unsigned nloc = b.st[0], nx = b.st[1];
        if (nloc == 0u) { xcd_barrier_complete(bar, b.x, nloc, nx); b.st[0] = nloc; b.st[1] = nx; }
        const unsigned old = xb_add(&bar[XB_XSUB(b.x)], 1u);
        const unsigned gen = old / nloc;
        if (old + 1u == (gen + 1u) * nloc) {
            __builtin_amdgcn_fence(__ATOMIC_RELEASE, "agent");
            asm volatile("s_waitcnt vmcnt(0)" ::: "memory");
            const unsigned og = xb_add(&bar[XB_TOP], 1u);
            const unsigned tg = og / nx;
            if (og + 1u == (tg + 1u) * nx) xb_add(&bar[XB_TOPGEN], 1u);
            else XB_SPIN(xb_ld(&bar[XB_TOPGEN]) == tg, bar);
            __builtin_amdgcn_fence(__ATOMIC_ACQUIRE, "agent");
            xb_add(&bar[XB_XGEN(b.x)], 1u);
            asm volatile("s_waitcnt vmcnt(0)" ::: "memory");
        } else {
            XB_SPIN(xb_ld(&bar[XB_XGEN(b.x)]) == gen, bar);
            __builtin_amdgcn_fence(__ATOMIC_ACQUIRE, "agent");
            asm volatile("s_waitcnt vmcnt(0)" ::: "memory");
        }
    }
    __syncthreads();
}

struct Frame {
    LAS unsigned char* lds;
    int tid, lane, wave, vcu, G;
    const Args* a;
    unsigned char* ws;
};
#define LDS_WAIT() asm volatile("s_waitcnt lgkmcnt(0)" ::: "memory")

struct TItem { const float* W; bf16* WT; int K, N, mode, r; };
__device__ __forceinline__ void transpose_load(const TItem& t, int lane, float (&tv)[32]) {
    const int nblk = (t.N + 31) / 32, kb = t.r / nblk, nb = t.r % nblk, k0 = 64 * kb, n0 = 32 * nb;
    int nn = n0 + (lane & 31); nn = nn < t.N ? nn : t.N - 1;
    const float* wp = t.W + (size_t)(k0 + (lane >> 5)) * t.N + nn;
#pragma unroll
    for (int i = 0; i < 32; ++i) tv[i] = wp[(size_t)(2 * i) * t.N];
}
__device__ __forceinline__ void transpose_store(const TItem& t, int lane, LAS float* scr, const float (&tv)[32]) {
    const int nblk = (t.N + 31) / 32, kb = t.r / nblk, nb = t.r % nblk, k0 = 64 * kb, n0 = 32 * nb;
    const bool okn = n0 + (lane & 31) < t.N;
#pragma unroll
    for (int i = 0; i < 32; ++i) { const int kk = 2 * i + (lane >> 5); scr[kk * 33 + (lane & 31)] = okn ? tv[i] : 0.f; }
    LDS_WAIT(); asm volatile("" ::: "memory");
    const int c = lane & 7;
    const int drow0 = (t.mode == 0 ? n0 : ((n0 >> 7) * 256 + (n0 & 127) + (t.mode == 2 ? 128 : 0)));
#pragma unroll
    for (int j = 0; j < 4; ++j) { const int n = (lane >> 3) + 8 * j; const LAS float* s = scr + (8 * c) * 33 + n;
        u32x4 o; o.x = cvt_pk_bf16(s[0 * 33], s[1 * 33]); o.y = cvt_pk_bf16(s[2 * 33], s[3 * 33]); o.z = cvt_pk_bf16(s[4 * 33], s[5 * 33]); o.w = cvt_pk_bf16(s[6 * 33], s[7 * 33]);
        *(u32x4*)(t.WT + (size_t)(drow0 + n) * t.K + k0 + 8 * c) = o; }
    LDS_WAIT(); asm volatile("" ::: "memory");
}
template <bool SILU, int NVEC>
__device__ __forceinline__ void block_gemv(Frame& F, const float* a0, const float* a1, int K, const float* W, int N, int col0, const float* bias, float* out0, float* out1) {
    const int col = col0 + F.lane, kper = K / NWAVES, kbeg = F.wave * kper;
    float s0 = 0.f, s1 = 0.f;
#pragma unroll 32
    for (int k = kbeg; k < kbeg + kper; ++k) {
        const float w = W[(size_t)k * N + col];
        float x0 = a0[k]; if (SILU) x0 = x0 / (1.f + __expf(-x0));
        s0 += x0 * w;
        if (NVEC == 2) { float x1 = a1[k]; if (SILU) x1 = x1 / (1.f + __expf(-x1)); s1 += x1 * w; }
    }
    LAS float* red = (LAS float*)(F.lds + RING_OFF);
    red[(F.wave * 2 + 0) * 64 + F.lane] = s0; red[(F.wave * 2 + 1) * 64 + F.lane] = s1;
    __syncthreads();
    if (F.wave == 0) {
        float t0 = 0.f, t1 = 0.f;
#pragma unroll
        for (int w = 0; w < NWAVES; ++w) { t0 += red[(w * 2 + 0) * 64 + F.lane]; t1 += red[(w * 2 + 1) * 64 + F.lane]; }
        const float bv = bias ? bias[col] : 0.f;
        out0[col] = t0 + bv; if (NVEC == 2) out1[col] = t1 + bv;
    }
    __syncthreads();
}
__device__ __forceinline__ void phase_prologue(Frame& F) {
    const Args& A = *F.a; unsigned char* ws = F.ws;
    for (int it = F.vcu; it < 208; it += F.G) {
        if (it < 192) { const int l = it / 96, cc = it % 96;
            float* mod = (float*)(ws + WS_MOD) + (size_t)l * 2 * 6144;
            block_gemv<true, 2>(F, A.in[1], A.in[1] + DM, DM, A.in[3] + (size_t)l * DM * 6144, 6144, cc * 64, A.in[4] + (size_t)l * 6144, mod, mod + 6144);
        } else { const int r = it - 192, lk = r / 4, cc = r % 4, l = lk >> 1, kv = lk & 1;
            const float* pos = A.in[kv ? 16 : 13] + (size_t)l * 2048; const float* w1 = A.in[kv ? 17 : 14] + (size_t)l * 2048 * 256;
            float* cb = (float*)(ws + WS_CBIAS) + (size_t)(l * 2 + kv) * 256;
            block_gemv<false, 1>(F, pos, pos, 2048, w1, 256, cc * 64, nullptr, cb, cb);
        }
    }
    LAS float* scr = (LAS float*)(F.lds + RING_OFF + F.wave * 16384);
    const int gw = F.vcu * NWAVES + F.wave, NGW = F.G * NWAVES;
    constexpr int PER_L = 1424 + 512 + 256 + 256 + 8 + 8, N_L = 2 * PER_L, N_F = 3 * 1408, PER_E = 3 * 1792, N_ALL = N_L + N_F + NE * PER_E;
    auto decode = [&](int it, TItem& t) {
        int r = it; const float* W; int K, N, mode = 0; bf16* WT;
        if (r < N_L) { const int l = r / PER_L; r %= PER_L;
            if (r < 1424) { W = A.in[9] + (size_t)l * DM * IN_COLS; K = DM; N = IN_COLS; WT = (bf16*)(ws + WS_WIN) + (size_t)l * NPROJ * DM; }
            else if (r < 1936) { r -= 1424; W = A.in[10] + (size_t)l * DM * DM; K = DM; N = DM; WT = (bf16*)(ws + WS_WOUT) + (size_t)l * DM * DM; }
            else if (r < 2192) { r -= 1936; W = A.in[14] + (size_t)l * 2048 * 256; K = 2048; N = 256; WT = (bf16*)(ws + WS_CW1) + (size_t)(l * 2 + 0) * 256 * 2048; }
            else if (r < 2448) { r -= 2192; W = A.in[17] + (size_t)l * 2048 * 256; K = 2048; N = 256; WT = (bf16*)(ws + WS_CW1) + (size_t)(l * 2 + 1) * 256 * 2048; }
            else if (r < 2456) { r -= 2448; W = A.in[15] + (size_t)l * 256 * 64; K = 256; N = 64; WT = (bf16*)(ws + WS_CW2) + (size_t)(l * 2 + 0) * 64 * 256; }
            else { r -= 2456; W = A.in[18] + (size_t)l * 256 * 64; K = 256; N = 64; WT = (bf16*)(ws + WS_CW2) + (size_t)(l * 2 + 1) * 64 * 256; }
        } else if (r < N_L + N_F) { r -= N_L; const int which = r / 1408; r %= 1408;
            if (which == 0) { W = A.in[19]; K = DM; N = DFF; WT = (bf16*)(ws + WS_FGU); mode = 1; }
            else if (which == 1) { W = A.in[20]; K = DM; N = DFF; WT = (bf16*)(ws + WS_FGU); mode = 2; }
            else { W = A.in[21]; K = DFF; N = DM; WT = (bf16*)(ws + WS_FD); }
        } else { r -= N_L + N_F; const int e = r / PER_E; r %= PER_E; const int which = r / 1792; r %= 1792;
            if (which == 0) { W = A.in[24] + (size_t)e * DM * DFE; K = DM; N = DFE; WT = (bf16*)(ws + WS_MGU) + (size_t)e * 7168 * DM; mode = 1; }
            else if (which == 1) { W = A.in[25] + (size_t)e * DM * DFE; K = DM; N = DFE; WT = (bf16*)(ws + WS_MGU) + (size_t)e * 7168 * DM; mode = 2; }
            else { W = A.in[26] + (size_t)e * DFE * DM; K = DFE; N = DM; WT = (bf16*)(ws + WS_MD) + (size_t)e * DM * DFE; }
        }
        t.W = W; t.WT = WT; t.K = K; t.N = N; t.mode = mode; t.r = r;
    };
    int it = gw; TItem ia, ib; float ta[32], tb[32];
    if (it < N_ALL) {
        decode(it, ia); transpose_load(ia, F.lane, ta);
        for (;;) {
            const int n1 = it + NGW; const bool h1 = n1 < N_ALL;
            decode(h1 ? n1 : it, ib); transpose_load(ib, F.lane, tb);
            transpose_store(ia, F.lane, scr, ta);
            if (!h1) break;
            const int n2 = n1 + NGW; const bool h2 = n2 < N_ALL;
            decode(h2 ? n2 : n1, ia); transpose_load(ia, F.lane, ta);
            transpose_store(ib, F.lane, scr, tb);
            if (!h2) break;
            it = n2;
        }
    }
}

__device__ __forceinline__ void ld_row(const float* p, int lane, f32x4 (&v)[4]) {
#pragma unroll
    for (int i = 0; i < 4; ++i) v[i] = ((const f32x4*)p)[lane + 64 * i];
}
__device__ __forceinline__ void ld_row_bf16(const bf16* p, int lane, f32x4 (&v)[4]) {
#pragma unroll
    for (int i = 0; i < 4; ++i) { const u32x2 w = ((const u32x2*)p)[lane + 64 * i]; v[i] = (f32x4){__uint_as_float(w.x << 16), __uint_as_float(w.x & 0xffff0000u), __uint_as_float(w.y << 16), __uint_as_float(w.y & 0xffff0000u)}; }
}
__device__ __forceinline__ float sumsq(const f32x4 (&v)[4]) {
    float s = 0.f;
#pragma unroll
    for (int i = 0; i < 4; ++i) s += (v[i].x * v[i].x + v[i].y * v[i].y) + (v[i].z * v[i].z + v[i].w * v[i].w);
    return s;
}
__device__ __forceinline__ void st_row_bf16(bf16* p, int lane, const f32x4 (&v)[4]) {
#pragma unroll
    for (int i = 0; i < 4; ++i) { u32x2 w; w.x = cvt_pk_bf16(v[i].x, v[i].y); w.y = cvt_pk_bf16(v[i].z, v[i].w); ((u32x2*)p)[lane + 64 * i] = w; }
}
__device__ __forceinline__ void modulate(const f32x4 (&x)[4], float r, const float* g, const float* scale, const float* shift, int lane, f32x4 (&h)[4]) {
    f32x4 gv[4], sc[4], sh[4]; ld_row(g, lane, gv); ld_row(scale, lane, sc); ld_row(shift, lane, sh);
#pragma unroll
    for (int i = 0; i < 4; ++i) h[i] = x[i] * r * gv[i] * (1.f + sc[i]) + sh[i];
}
__device__ __forceinline__ void phase_h0(Frame& F) {
    const Args& A = *F.a; const float* mod = (const float*)(F.ws + WS_MOD);
    bf16* H = (bf16*)(F.ws + WS_H);
    for (int row = F.vcu * NWAVES + F.wave; row < T; row += F.G * NWAVES) {
        const int b = row >> 13; const float* mb = mod + (size_t)(0 * 2 + b) * 6144;
        f32x4 x[4], h[4]; ld_row(A.in[0] + (size_t)row * DM, F.lane, x);
        const float r = 1.f / sqrtf(wave_sum(sumsq(x)) * (1.f / DM) + EPS);
        modulate(x, r, A.in[5], mb + 1024, mb, F.lane, h);
        st_row_bf16(H + (size_t)row * DM, F.lane, h);
    }
}
__device__ __forceinline__ void phase_merge(Frame& F, int layer) {
    const Args& A = *F.a; const float* oraw = (const float*)(F.ws + AR_ORAW); bf16* H = (bf16*)(F.ws + WS_H);
    const float* gsb = A.in[11] + layer * 512; const float* gns = A.in[12] + layer * 512;
    for (int row = F.vcu * NWAVES + F.wave; row < T; row += F.G * NWAVES) {
        f32x4 v[4]; ld_row(oraw + (size_t)row * DM, F.lane, v);
        float s0 = (v[0].x * v[0].x + v[0].y * v[0].y) + (v[0].z * v[0].z + v[0].w * v[0].w) + (v[1].x * v[1].x + v[1].y * v[1].y) + (v[1].z * v[1].z + v[1].w * v[1].w);
        float s1 = (v[2].x * v[2].x + v[2].y * v[2].y) + (v[2].z * v[2].z + v[2].w * v[2].w) + (v[3].x * v[3].x + v[3].y * v[3].y) + (v[3].z * v[3].z + v[3].w * v[3].w);
        const float r0 = 1.f / sqrtf(wave_sum(s0) * (1.f / 512) + EPS), r1 = 1.f / sqrtf(wave_sum(s1) * (1.f / 512) + EPS);
        f32x4 o[4];
#pragma unroll
        for (int i = 0; i < 2; ++i) { o[i] = v[i] * r0 * ((const f32x4*)gsb)[F.lane + 64 * i]; o[2 + i] = v[2 + i] * r1 * ((const f32x4*)gns)[F.lane + 64 * i]; }
        st_row_bf16(H + (size_t)row * DM, F.lane, o);
    }
}
__device__ __forceinline__ void phase_post_mix(Frame& F, int layer) {
    const Args& A = *F.a; const float* mod = (const float*)(F.ws + WS_MOD);
    const bf16* mbuf = (const bf16*)(F.ws + AR_M); bf16* H = (bf16*)(F.ws + WS_H);
    const float* xin = layer == 0 ? A.in[0] : A.out;
    unsigned* cnt = (unsigned*)(F.ws + WS_CTL) + CW_CNT; unsigned* tokinfo = (unsigned*)(F.ws + AR_TOKINFO);
    for (int row = F.vcu * NWAVES + F.wave; row < T; row += F.G * NWAVES) {
        const int b = row >> 13; const float* mb = mod + (size_t)(layer * 2 + b) * 6144;
        f32x4 x[4], m[4], g[4], gt[4], h[4];
        ld_row(xin + (size_t)row * DM, F.lane, x); ld_row_bf16(mbuf + (size_t)row * DM, F.lane, m);
        ld_row(A.in[6] + layer * DM, F.lane, g); ld_row(mb + 2048, F.lane, gt);
        const float r = 1.f / sqrtf(wave_sum(sumsq(m)) * (1.f / DM) + EPS);
#pragma unroll
        for (int i = 0; i < 4; ++i) { x[i] = x[i] + gt[i] * (m[i] * r * g[i]); ((f32x4*)(A.out + (size_t)row * DM))[F.lane + 64 * i] = x[i]; }
        const float r2 = 1.f / sqrtf(wave_sum(sumsq(x)) * (1.f / DM) + EPS);
        modulate(x, r2, A.in[7] + layer * DM, mb + 4096, mb + 3072, F.lane, h);
        st_row_bf16(H + (size_t)row * DM, F.lane, h);
        if (layer == 1) {
            const float* wr = A.in[22]; float lg[8];
#pragma unroll
            for (int e = 0; e < 8; ++e) lg[e] = 0.f;
#pragma unroll
            for (int i = 0; i < 4; ++i)
#pragma unroll
                for (int j = 0; j < 4; ++j) { const int k = i * 256 + F.lane * 4 + j; const f32x4 w0 = *(const f32x4*)(wr + k * 8), w1 = *(const f32x4*)(wr + k * 8 + 4); const float hv = h[i][j];
                    lg[0] += hv * w0.x; lg[1] += hv * w0.y; lg[2] += hv * w0.z; lg[3] += hv * w0.w; lg[4] += hv * w1.x; lg[5] += hv * w1.y; lg[6] += hv * w1.z; lg[7] += hv * w1.w; }
            float mx = -3.0e38f;
#pragma unroll
            for (int e = 0; e < 8; ++e) { lg[e] = wave_sum(lg[e]) + A.in[23][e]; mx = fmaxf(mx, lg[e]); }
            float p[8], sum = 0.f;
#pragma unroll
            for (int e = 0; e < 8; ++e) { p[e] = __expf(lg[e] - mx); sum += p[e]; }
            const float inv = 1.f / sum;
#pragma unroll
            for (int e = 0; e < 8; ++e) p[e] *= inv;
            int e0 = 0; float p0 = p[0];
#pragma unroll
            for (int e = 1; e < 8; ++e) if (p[e] > p0) { p0 = p[e]; e0 = e; }
            int e1 = -1; float p1 = -1.f;
#pragma unroll
            for (int e = 0; e < 8; ++e) if (e != e0 && p[e] > p1) { p1 = p[e]; e1 = e; }
            const float ws2 = p0 + p1;
            if (F.lane == 0) {
                const unsigned pos0 = atomicAdd(&cnt[e0], 1u), pos1 = atomicAdd(&cnt[e1], 1u);
                u32x4 a0, a1; a0.x = (unsigned)e0; a0.y = (unsigned)e1; a0.z = pos0; a0.w = pos1;
                a1.x = __float_as_uint(p0 / ws2); a1.y = __float_as_uint(p1 / ws2); a1.z = 0u; a1.w = 0u;
                *(u32x4*)(tokinfo + (size_t)row * 8) = a0; *(u32x4*)(tokinfo + (size_t)row * 8 + 4) = a1;
                int* rowtok = (int*)(F.ws + AR_ROWTOK);
                rowtok[e0 * 16384 + (int)pos0] = row; rowtok[e1 * 16384 + (int)pos1] = row;
            }
        }
    }
}
constexpr int MOETBL_OFF = LDSCTL_OFF + 1280;
__device__ __forceinline__ void moe_table_build(Frame& F) {
    LAS int* tbl = (LAS int*)(F.lds + MOETBL_OFF);
    if (F.tid == 0) {
        unsigned* cnt = (unsigned*)(F.ws + WS_CTL) + CW_CNT; int acc = 0;
        for (int e = 0; e < 8; ++e) { const int c = (int)__hip_atomic_load(&cnt[e], __ATOMIC_RELAXED, __HIP_MEMORY_SCOPE_AGENT); tbl[e] = acc; tbl[8 + e] = c; tbl[16 + e] = (c + 255) >> 8; acc += (c + 255) >> 8; }
        int nfull = acc, S = 1;
        if ((F.G & 3) == 0) { const int nf = (acc * 4 / F.G) * (F.G / 4), ntail = acc - nf; if (ntail > 0 && ntail <= 8 && ntail * 28 <= F.G) { nfull = nf; S = 7; } }
        tbl[24] = nfull; tbl[25] = S;
    }
    __syncthreads();
}
__device__ __forceinline__ void moe_y_row(Frame& F, int r, int tail0, int nS, f32x4 (&y)[4]) {
    if (r < tail0 || nS <= 1) { ld_row_bf16((const bf16*)(F.ws + WS_Y) + (size_t)r * DM, F.lane, y); return; }
    const bf16* pp = (const bf16*)(F.ws + WS_YPART) + (size_t)(r - tail0) * DM;
    ld_row_bf16(pp, F.lane, y);
    for (int s = 1; s < nS; ++s) { f32x4 t[4]; ld_row_bf16(pp + (size_t)s * 2048 * DM, F.lane, t);
#pragma unroll
        for (int i = 0; i < 4; ++i) y[i] = y[i] + t[i]; }
}
__device__ __forceinline__ void phase_post_ffn(Frame& F, int layer) {
    const Args& A = *F.a; const float* mod = (const float*)(F.ws + WS_MOD); bf16* H = (bf16*)(F.ws + WS_H);
    if (layer == 1) moe_table_build(F);
    const LAS int* tbl = (const LAS int*)(F.lds + MOETBL_OFF);
    const unsigned* tokinfo = (const unsigned*)(F.ws + AR_TOKINFO);
    for (int row = F.vcu * NWAVES + F.wave; row < T; row += F.G * NWAVES) {
        const int b = row >> 13; const float* mb = mod + (size_t)(layer * 2 + b) * 6144;
        f32x4 x[4], f[4], g[4], gt[4];
        ld_row(A.out + (size_t)row * DM, F.lane, x);
        if (layer == 0) ld_row_bf16((const bf16*)(F.ws + AR_FOUT) + (size_t)row * DM, F.lane, f);
        else {
            const u32x4 a0 = *(const u32x4*)(tokinfo + (size_t)row * 8), a1 = *(const u32x4*)(tokinfo + (size_t)row * 8 + 4);
            const int r0 = tbl[a0.x] * 256 + (int)a0.z, r1 = tbl[a0.y] * 256 + (int)a0.w;
            const float w0 = __uint_as_float(a1.x), w1 = __uint_as_float(a1.y);
            f32x4 y0[4], y1[4]; const int tail0 = tbl[24] * 256, nS = tbl[25];
            moe_y_row(F, r0, tail0, nS, y0); moe_y_row(F, r1, tail0, nS, y1);
#pragma unroll
            for (int i = 0; i < 4; ++i) f[i] = y0[i] * w0 + y1[i] * w1;
        }
        ld_row(A.in[8] + layer * DM, F.lane, g); ld_row(mb + 5120, F.lane, gt);
        const float r = 1.f / sqrtf(wave_sum(sumsq(f)) * (1.f / DM) + EPS);
#pragma unroll
        for (int i = 0; i < 4; ++i) { x[i] = x[i] + gt[i] * (f[i] * r * g[i]); ((f32x4*)(A.out + (size_t)row * DM))[F.lane + 64 * i] = x[i]; }
        if (layer == 0) {
            const float* mb1 = mod + (size_t)(1 * 2 + b) * 6144; f32x4 h[4];
            const float r2 = 1.f / sqrtf(wave_sum(sumsq(x)) * (1.f / DM) + EPS);
            modulate(x, r2, A.in[5] + DM, mb1 + 1024, mb1, F.lane, h);
            st_row_bf16(H + (size_t)row * DM, F.lane, h);
        }
    }
}

__device__ __forceinline__ float gelu_tanh(float x) { const float u = 0.7978845608028654f * (x + 0.044715f * x * x * x); const float t = 1.f - 2.f / (__expf(2.f * u) + 1.f); return 0.5f * x * (1.f + t); }
__device__ __forceinline__ void cmp_out_unit(Frame& F, int layer, int pm) {
    const int t = pm >> 1, kv = t >> 2, bg = t & 3, rbase = (pm & 1) * 256;
    const bf16* hid = (const bf16*)(F.ws + AR_CHID) + (size_t)pm * 256 * 256;
    const bf16* w2t = (const bf16*)(F.ws + WS_CW2) + (size_t)(layer * 2 + kv) * 64 * 256;
    bf16* outp = (bf16*)(F.ws + AR_KC) + (size_t)(kv * 4 + bg) * 512 * 64;
    const int w = F.wave, fr = F.lane & 15, fq = F.lane >> 4;
    f32x4 acc[2][4];
#pragma unroll
    for (int m = 0; m < 2; ++m)
#pragma unroll
        for (int n = 0; n < 4; ++n) acc[m][n] = (f32x4){0.f, 0.f, 0.f, 0.f};
#pragma unroll
    for (int kk = 0; kk < 8; ++kk) {
        bf16x8 a[2], b[4];
#pragma unroll
        for (int m = 0; m < 2; ++m) a[m] = *(const bf16x8*)(hid + (size_t)(w * 32 + m * 16 + fr) * 256 + kk * 32 + fq * 8);
#pragma unroll
        for (int n = 0; n < 4; ++n) b[n] = *(const bf16x8*)(w2t + (size_t)(n * 16 + fr) * 256 + kk * 32 + fq * 8);
#pragma unroll
        for (int m = 0; m < 2; ++m)
#pragma unroll
            for (int n = 0; n < 4; ++n) acc[m][n] = __builtin_amdgcn_mfma_f32_16x16x32_bf16(a[m], b[n], acc[m][n], 0, 0, 0);
    }
#pragma unroll
    for (int m = 0; m < 2; ++m)
#pragma unroll
        for (int n = 0; n < 4; ++n)
#pragma unroll
            for (int r = 0; r < 4; ++r) { const int row = rbase + w * 32 + m * 16 + fq * 4 + r, col = n * 16 + fr;
                const bf16 ov = row < NCMP ? (bf16)(cvt_pk_bf16(acc[m][n][r], 0.f) & 0xffffu) : (bf16)0;
                outp[kv == 0 ? koff(row, col) : voff(row, col)] = ov; }
}

struct KF { bf16x8 lo, hi; };
__device__ __forceinline__ int lane_off(int lane) { return (lane >> 4) * 128 + (lane & 15) * 8; }
__device__ __forceinline__ KF ld_kf(const bf16* row, int fq) { KF k; k.lo = *(const bf16x8*)(row + 8 * fq); k.hi = *(const bf16x8*)(row + 32 + 8 * fq); return k; }
__device__ __forceinline__ KF ld_kt(const bf16* Kt, int k0, int lane) { KF k; const bf16* p = Kt + (size_t)(k0 >> 4) * 1024 + lane_off(lane); k.lo = *(const bf16x8*)p; k.hi = *(const bf16x8*)(p + 512); return k; }
__device__ __forceinline__ bf16x8 ld_vt(const bf16* Vt, int k0, int dt, int lane) { return *(const bf16x8*)(Vt + (size_t)(k0 >> 5) * 2048 + dt * 512 + lane_off(lane)); }
__device__ __forceinline__ f32x4 qk16(const KF& k, const KF& q) { f32x4 z = {0.f, 0.f, 0.f, 0.f}; z = __builtin_amdgcn_mfma_f32_16x16x32_bf16(k.lo, q.lo, z, 0, 0, 0); z = __builtin_amdgcn_mfma_f32_16x16x32_bf16(k.hi, q.hi, z, 0, 0, 0); return z; }
__device__ __forceinline__ bf16x8 pack_p(const f32x4& p0, const f32x4& p1) { const u32x4 w = {cvt_pk_bf16(p0[0], p0[1]), cvt_pk_bf16(p0[2], p0[3]), cvt_pk_bf16(p1[0], p1[1]), cvt_pk_bf16(p1[2], p1[3])}; return __builtin_bit_cast(bf16x8, w); }
__device__ __forceinline__ float fq_max(float v) {
    auto a = __builtin_amdgcn_permlane16_swap(__float_as_uint(v), __float_as_uint(v), false, false); v = fmaxf(__uint_as_float(a[0]), __uint_as_float(a[1]));
    auto b = __builtin_amdgcn_permlane32_swap(__float_as_uint(v), __float_as_uint(v), false, false); return fmaxf(__uint_as_float(b[0]), __uint_as_float(b[1])); }
__device__ __forceinline__ float fq_sum(float v) {
    auto a = __builtin_amdgcn_permlane16_swap(__float_as_uint(v), __float_as_uint(v), false, false); v = __uint_as_float(a[0]) + __uint_as_float(a[1]);
    auto b = __builtin_amdgcn_permlane32_swap(__float_as_uint(v), __float_as_uint(v), false, false); return __uint_as_float(b[0]) + __uint_as_float(b[1]); }
__device__ __forceinline__ float xor16f(float v) { auto a = __builtin_amdgcn_permlane16_swap(__float_as_uint(v), __float_as_uint(v), false, false); return __uint_as_float(((threadIdx.x >> 4) & 1) ? a[0] : a[1]); }
__device__ __forceinline__ float xor32f(float v) { auto a = __builtin_amdgcn_permlane32_swap(__float_as_uint(v), __float_as_uint(v), false, false); return __uint_as_float(((threadIdx.x >> 5) & 1) ? a[0] : a[1]); }
__device__ __forceinline__ float quad_x1(float v) { return __uint_as_float(__builtin_amdgcn_update_dpp(0, __float_as_uint(v), 0xB1, 0xf, 0xf, true)); }
__device__ __forceinline__ float quad_x2(float v) { return __uint_as_float(__builtin_amdgcn_update_dpp(0, __float_as_uint(v), 0x4E, 0xf, 0xf, true)); }
constexpr float QK_C = 0.125f * 1.4426950408889634f;
constexpr float NEG_INF = -__builtin_huge_valf();
__device__ __forceinline__ bf16x8 osm_step(f32x4& s0, f32x4& s1, float& m, float& l, f32x4 (&O)[4]) {
    float smax = fmaxf(fmaxf(fmaxf(s0[0], s0[1]), fmaxf(s0[2], s0[3])), fmaxf(fmaxf(s1[0], s1[1]), fmaxf(s1[2], s1[3])));
    smax = fq_max(smax);
    {
        const float mnew = fmaxf(m, smax), muse = (mnew == NEG_INF) ? 0.f : mnew;
        const float alpha = __builtin_amdgcn_exp2f(m - muse);
        l *= alpha; m = mnew;
#pragma unroll
        for (int dt = 0; dt < 4; ++dt) O[dt] = O[dt] * alpha;
    }
    const float muse = (m == NEG_INF) ? 0.f : m;
    float ps = 0.f;
#pragma unroll
    for (int r = 0; r < 4; ++r) { s0[r] = __builtin_amdgcn_exp2f(s0[r] - muse); s1[r] = __builtin_amdgcn_exp2f(s1[r] - muse); ps += s0[r] + s1[r]; }
    l += ps;
    return pack_p(s0, s1);
}

__device__ __forceinline__ long osm_step8(f32x4& s0, f32x4& s1, float& m, float& l, f32x4 (&O)[4]) {
    float smax = fmaxf(fmaxf(fmaxf(s0[0], s0[1]), fmaxf(s0[2], s0[3])), fmaxf(fmaxf(s1[0], s1[1]), fmaxf(s1[2], s1[3])));
    smax = fq_max(smax);
    {
        const float mnew = fmaxf(m, smax), muse = (mnew == NEG_INF) ? 0.f : mnew;
        const float alpha = __builtin_amdgcn_exp2f(m - muse);
        l *= alpha; m = mnew;
#pragma unroll
        for (int dt = 0; dt < 4; ++dt) O[dt] = O[dt] * alpha;
    }
    const float muse = ((m == NEG_INF) ? 0.f : m) - 6.f;
    float ps = 0.f;
#pragma unroll
    for (int r = 0; r < 4; ++r) { s0[r] = __builtin_amdgcn_exp2f(s0[r] - muse); s1[r] = __builtin_amdgcn_exp2f(s1[r] - muse); ps += s0[r] + s1[r]; }
    l += ps;
    const unsigned w0 = cvt4_fp8(s0[0], s0[1], s0[2], s0[3]), w1 = cvt4_fp8(s1[0], s1[1], s1[2], s1[3]);
    return (long)(((unsigned long long)w1 << 32) | w0);
}

__device__ __forceinline__ void win_task(Frame& F, int task) {
    const int bg = task >> 9, t0 = (task & 511) * 16, b = bg >> 1, g = bg & 1, fr = F.lane & 15, fq = F.lane >> 4, t = t0 + fr;
    const bf16* Kp = (const bf16*)(F.ws + AR_NKV) + (size_t)((2 * 2 + 0) * 4 + bg) * SEQ * 64;
    const bf16* VT = (const bf16*)(F.ws + AR_NKV) + (size_t)((2 * 2 + 1) * 4 + bg) * SEQ * 64;
    const bf16* Q = (const bf16*)(F.ws + AR_NQ) + ((size_t)(b * 8 + g * 4) * SEQ + t) * 64;
    const LAS float* bl = (const LAS float*)(F.lds + BIASL_OFF) + (g * 4) * 132;
    KF qf[4]; f32x4 O[4][4]; float m[4], l[4];
#pragma unroll
    for (int z = 0; z < 4; ++z) { qf[z] = ld_kf(Q + (size_t)z * SEQ * 64, fq); m[z] = NEG_INF; l[z] = 0.f;
#pragma unroll
        for (int dt = 0; dt < 4; ++dt) O[z][dt] = (f32x4){0.f, 0.f, 0.f, 0.f}; }
    int kstart = t0 - 511; kstart = kstart < 0 ? 0 : (kstart & ~31);
    KF ka = ld_kt(Kp, kstart, F.lane), kb = ld_kt(Kp, kstart + 16, F.lane);
    bf16x8 vf[4];
#pragma unroll
    for (int dt = 0; dt < 4; ++dt) vf[dt] = ld_vt(VT, kstart, dt, F.lane);
#pragma clang loop unroll(disable)
    for (int k0 = kstart; k0 <= t0 + 15; k0 += 32) {
        const int kn = (k0 + 32 <= t0 + 15) ? k0 + 32 : k0;
        const KF nka = ld_kt(Kp, kn, F.lane), nkb = ld_kt(Kp, kn + 16, F.lane);
        bf16x8 nvf[4];
#pragma unroll
        for (int dt = 0; dt < 4; ++dt) nvf[dt] = ld_vt(VT, kn, dt, F.lane);
        const int d0 = t - (k0 + 4 * fq);
        const bool interior = (k0 + 31 + 128 <= t0) && (t0 + 15 - k0 < 512);
        f32x4 s0[4], s1[4]; bf16x8 pf[4];
#pragma unroll
        for (int z = 0; z < 4; ++z) { s0[z] = qk16(ka, qf[z]); s1[z] = qk16(kb, qf[z]); }
        if (interior) {
#pragma unroll
            for (int z = 0; z < 4; ++z) { const float bb = bl[z * 132 + 128];
#pragma unroll
                for (int r = 0; r < 4; ++r) { s0[z][r] = s0[z][r] * QK_C + bb; s1[z][r] = s1[z][r] * QK_C + bb; } }
        } else {
#pragma unroll
            for (int z = 0; z < 4; ++z)
#pragma unroll
                for (int r = 0; r < 4; ++r) {
                    const int da = d0 - r, db = d0 - 16 - r;
                    const int ia = da < 0 ? 0 : (da > 128 ? 128 : da), ib = db < 0 ? 0 : (db > 128 ? 128 : db);
                    s0[z][r] = ((unsigned)da < 512u) ? s0[z][r] * QK_C + bl[z * 132 + ia] : NEG_INF;
                    s1[z][r] = ((unsigned)db < 512u) ? s1[z][r] * QK_C + bl[z * 132 + ib] : NEG_INF;
                }
        }
#pragma unroll
        for (int z = 0; z < 4; ++z) pf[z] = osm_step(s0[z], s1[z], m[z], l[z], O[z]);
#pragma unroll
        for (int z = 0; z < 4; ++z)
#pragma unroll
            for (int dt = 0; dt < 4; ++dt) O[z][dt] = __builtin_amdgcn_mfma_f32_16x16x32_bf16(vf[dt], pf[z], O[z][dt], 0, 0, 0);
        ka = nka; kb = nkb;
#pragma unroll
        for (int dt = 0; dt < 4; ++dt) vf[dt] = nvf[dt];
    }
    const float* gt = (const float*)(F.ws + AR_GATES) + (size_t)(b * SEQ + t) * 24 + (g * 4) * 3 + 2;
    float* op = (float*)(F.ws + AR_OWIN) + (size_t)(b * SEQ + t) * 512 + (g * 4) * 64 + 4 * fq;
#pragma unroll
    for (int z = 0; z < 4; ++z) { const float sc = gt[z * 3] / fmaxf(fq_sum(l[z]), 1e-30f);
#pragma unroll
        for (int dt = 0; dt < 4; ++dt) *(f32x4*)(op + z * 64 + 16 * dt) = O[z][dt] * sc; }
}


__device__ __forceinline__ void sb_task(Frame& F, int task) {
    const int bh = task >> 9, t0 = (task & 511) * 16, fr = F.lane & 15, fq = F.lane >> 4, t = t0 + fr;
    const bf16* Kp = (const bf16*)(F.ws + AR_SBK) + (size_t)bh * SEQ * 64;
    const bf16* VT = (const bf16*)(F.ws + AR_SBV) + (size_t)bh * SEQ * 64;
    const KF qf = ld_kf((const bf16*)(F.ws + AR_SBQ) + ((size_t)bh * SEQ + t) * 64, fq);
    f32x4 O[4];
#pragma unroll
    for (int dt = 0; dt < 4; ++dt) O[dt] = (f32x4){0.f, 0.f, 0.f, 0.f};
    float carry = 0.f;
    const bool g1 = (fq ^ 1) > fq, g2 = (fq ^ 2) > fq, g3 = (fq ^ 3) > fq;
    const int kfirst = (t0 + 14) & ~31;
    KF ka = ld_kt(Kp, kfirst, F.lane), kb = ld_kt(Kp, kfirst + 16, F.lane);
    bf16x8 vf[4];
#pragma unroll
    for (int dt = 0; dt < 4; ++dt) vf[dt] = ld_vt(VT, kfirst, dt, F.lane);
#pragma clang loop unroll(disable)
    for (int k0 = kfirst; k0 >= 0; k0 -= 32) {
        const int kn = k0 >= 32 ? k0 - 32 : k0;
        const KF nka = ld_kt(Kp, kn, F.lane), nkb = ld_kt(Kp, kn + 16, F.lane);
        bf16x8 nvf[4];
#pragma unroll
        for (int dt = 0; dt < 4; ++dt) nvf[dt] = ld_vt(VT, kn, dt, F.lane);
        f32x4 z0 = qk16(ka, qf), z1 = qk16(kb, qf), L0, L1;
        const int key0 = k0 + 4 * fq;
#pragma unroll
        for (int r = 0; r < 4; ++r) {
            z0[r] *= QK_C; z1[r] *= QK_C;
            const float la = fmaxf(z0[r], 0.f) + __builtin_amdgcn_logf(1.f + __builtin_amdgcn_exp2f(-fabsf(z0[r])));
            const float lb = fmaxf(z1[r], 0.f) + __builtin_amdgcn_logf(1.f + __builtin_amdgcn_exp2f(-fabsf(z1[r])));
            L0[r] = (key0 + r < t) ? la : 0.f;
            L1[r] = (key0 + 16 + r < t) ? lb : 0.f;
        }
        f32x4 c0, c1;
        c1[3] = L1[3]; c1[2] = c1[3] + L1[2]; c1[1] = c1[2] + L1[1]; c1[0] = c1[1] + L1[0];
        c0[3] = L0[3]; c0[2] = c0[3] + L0[2]; c0[1] = c0[2] + L0[1]; c0[0] = c0[1] + L0[0];
        const float a1 = xor16f(c1[0]), a2 = xor32f(c1[0]), a3 = xor32f(a1);
        const float b1 = xor16f(c0[0]), b2 = xor32f(c0[0]), b3 = xor32f(b1);
        const float tot1 = c1[0] + a1 + a2 + a3, tot0 = c0[0] + b1 + b2 + b3;
        const float e1 = carry + (g1 ? a1 : 0.f) + (g2 ? a2 : 0.f) + (g3 ? a3 : 0.f);
        const float e0 = carry + tot1 + (g1 ? b1 : 0.f) + (g2 ? b2 : 0.f) + (g3 ? b3 : 0.f);
        f32x4 p0, p1;
#pragma unroll
        for (int r = 0; r < 4; ++r) {
            const float pa = __builtin_amdgcn_exp2f(z0[r] - (e0 + c0[r])), pb = __builtin_amdgcn_exp2f(z1[r] - (e1 + c1[r]));
            p0[r] = (key0 + r < t) ? pa : 0.f;
            p1[r] = (key0 + 16 + r < t) ? pb : 0.f;
        }
        carry += tot1 + tot0;
        const bf16x8 pf = pack_p(p0, p1);
#pragma unroll
        for (int dt = 0; dt < 4; ++dt) O[dt] = __builtin_amdgcn_mfma_f32_16x16x32_bf16(vf[dt], pf, O[dt], 0, 0, 0);
        if (__all(carry > 159.f)) break;
        ka = nka; kb = nkb;
#pragma unroll
        for (int dt = 0; dt < 4; ++dt) vf[dt] = nvf[dt];
    }
    float* op = (float*)(F.ws + AR_ORAW) + (size_t)((bh >> 3) * SEQ + t) * DM + (bh & 7) * 64 + 4 * fq;
#pragma unroll
    for (int dt = 0; dt < 4; ++dt) *(f32x4*)(op + 16 * dt) = O[dt];
}


__device__ __forceinline__ void nsa_task(Frame& F, int task) {
    const int bg = task >> 11, tq_ = task & 2047, tb = (2047 - tq_) * 4, b = bg >> 1,
                g = bg & 1, fr = F.lane & 15, fq = F.lane >> 4, tl = fr >> 2, z = fr & 3, t = tb + tl, hh = g * 4 + z;
    LAS float* imp = (LAS float*)(F.lds + RING_OFF + F.wave * 8192);
    LAS unsigned char* sel = (LAS unsigned char*)(F.lds + RING_OFF + F.wave * 8192 + 4224);
    const bf16* KC = (const bf16*)(F.ws + AR_KC) + (size_t)(0 * 4 + bg) * 512 * 64;
    const bf16* VCT = (const bf16*)(F.ws + AR_KC) + (size_t)(1 * 4 + bg) * 512 * 64;
    const bf16* KS = (const bf16*)(F.ws + AR_NKV) + (size_t)((1 * 2 + 0) * 4 + bg) * SEQ * 64;
    const bf16* VST = (const bf16*)(F.ws + AR_NKV) + (size_t)((1 * 2 + 1) * 4 + bg) * SEQ * 64;
    const bf16* Qg = (const bf16*)(F.ws + AR_NQ) + (size_t)(b * 8 + g * 4) * SEQ * 64;
    const float* gates = (const float*)(F.ws + AR_GATES);
    const LAS float* bl = (const LAS float*)(F.lds + BIASL_OFF) + hh * 132;
    for (int i = F.lane; i < 2 * 4 * 132; i += 64) imp[i] = 0.f;
    const KF qf = ld_kf(Qg + ((size_t)z * SEQ + t) * 64, fq);
    int nvis = t >= 31 ? ((t - 31) >> 4) + 1 : 0; nvis = nvis > NCMP ? NCMP : nvis;
    int nmax = (tb + 3) >= 31 ? ((tb + 3 - 31) >> 4) + 1 : 0; nmax = nmax > NCMP ? NCMP : nmax;
    const int dbase = t - 31 - 16 * (4 * fq);
    const float bfar = bl[128];
    float m = NEG_INF, l = 0.f;
    KF ka = ld_kt(KC, 0, F.lane), kb = ld_kt(KC, 16, F.lane);
#pragma clang loop unroll(disable)
    for (int n0 = 0; n0 < nmax; n0 += 32) {
        const int nn = n0 + 32 < nmax ? n0 + 32 : n0;
        const KF nka = ld_kt(KC, nn, F.lane), nkb = ld_kt(KC, nn + 16, F.lane);
        f32x4 s0 = qk16(ka, qf), s1 = qk16(kb, qf);
        ka = nka; kb = nkb;
        if (16 * (n0 + 31) + 31 + 128 <= tb) {
#pragma unroll
            for (int r = 0; r < 4; ++r) { s0[r] = s0[r] * QK_C + bfar; s1[r] = s1[r] * QK_C + bfar; }
        } else {
#pragma unroll
        for (int r = 0; r < 4; ++r) {
            const int na = n0 + 4 * fq + r, nb = na + 16, da = dbase - 16 * (n0 + r), db = da - 256;
            const int ia = da < 0 ? 0 : (da > 128 ? 128 : da), ib = db < 0 ? 0 : (db > 128 ? 128 : db);
            s0[r] = na < nvis ? s0[r] * QK_C + bl[ia] : NEG_INF;
            s1[r] = nb < nvis ? s1[r] * QK_C + bl[ib] : NEG_INF;
        }
        }
        float smax = fq_max(fmaxf(fmaxf(fmaxf(s0[0], s0[1]), fmaxf(s0[2], s0[3])), fmaxf(fmaxf(s1[0], s1[1]), fmaxf(s1[2], s1[3]))));
        const float mnew = fmaxf(m, smax), muse = (mnew == NEG_INF) ? 0.f : mnew;
        float ps = 0.f;
#pragma unroll
        for (int r = 0; r < 4; ++r) ps += __builtin_amdgcn_exp2f(s0[r] - muse) + __builtin_amdgcn_exp2f(s1[r] - muse);
        l = l * __builtin_amdgcn_exp2f(m - muse) + ps; m = mnew;
    }
    const float muse = (m == NEG_INF) ? 0.f : m, inv = 1.f / fmaxf(fq_sum(l), 1e-30f);
    f32x4 O[4];
#pragma unroll
    for (int dt = 0; dt < 4; ++dt) O[dt] = (f32x4){0.f, 0.f, 0.f, 0.f};
    LDS_WAIT();
    ka = ld_kt(KC, 0, F.lane); kb = ld_kt(KC, 16, F.lane);
    bf16x8 vc[4];
#pragma unroll
    for (int dt = 0; dt < 4; ++dt) vc[dt] = ld_vt(VCT, 0, dt, F.lane);
#pragma clang loop unroll(disable)
    for (int n0 = 0; n0 < nmax; n0 += 32) {
        const int nn = n0 + 32 < nmax ? n0 + 32 : n0;
        const KF nka = ld_kt(KC, nn, F.lane), nkb = ld_kt(KC, nn + 16, F.lane);
        bf16x8 nvc[4];
#pragma unroll
        for (int dt = 0; dt < 4; ++dt) nvc[dt] = ld_vt(VCT, nn, dt, F.lane);
        f32x4 s0 = qk16(ka, qf), s1 = qk16(kb, qf);
        ka = nka; kb = nkb;
        if (16 * (n0 + 31) + 31 + 128 <= tb) { const float bm = bfar - muse;
#pragma unroll
            for (int r = 0; r < 4; ++r) { s0[r] = __builtin_amdgcn_exp2f(s0[r] * QK_C + bm) * inv; s1[r] = __builtin_amdgcn_exp2f(s1[r] * QK_C + bm) * inv; }
        } else {
#pragma unroll
        for (int r = 0; r < 4; ++r) {
            const int na = n0 + 4 * fq + r, nb = na + 16, da = dbase - 16 * (n0 + r), db = da - 256;
            const int ia = da < 0 ? 0 : (da > 128 ? 128 : da), ib = db < 0 ? 0 : (db > 128 ? 128 : db);
            s0[r] = na < nvis ? __builtin_amdgcn_exp2f(s0[r] * QK_C + bl[ia] - muse) * inv : 0.f;
            s1[r] = nb < nvis ? __builtin_amdgcn_exp2f(s1[r] * QK_C + bl[ib] - muse) * inv : 0.f;
        }
        }
        const bf16x8 pf = pack_p(s0, s1);
#pragma unroll
        for (int dt = 0; dt < 4; ++dt) { O[dt] = __builtin_amdgcn_mfma_f32_16x16x32_bf16(vc[dt], pf, O[dt], 0, 0, 0); vc[dt] = nvc[dt]; }
        float x0 = (s0[0] + s0[1]) + (s0[2] + s0[3]), y0 = s0[3], x1 = (s1[0] + s1[1]) + (s1[2] + s1[3]), y1 = s1[3];
        x0 += quad_x1(x0); x0 += quad_x2(x0); y0 += quad_x1(y0); y0 += quad_x2(y0);
        x1 += quad_x1(x1); x1 += quad_x2(x1); y1 += quad_x1(y1); y1 += quad_x2(y1);
        if (z == 0) { LAS float* ip = imp + tl * 132 + (n0 >> 2) + fq;
            ip[0] = x0; ip[4] = x1; ip[528 + 1] = y0; ip[528 + 5] = y1; }
    }
    {
        const float gc = gates[(size_t)(b * SEQ + t) * 24 + hh * 3 + 0];
        const float* ow = (const float*)(F.ws + AR_OWIN) + (size_t)(b * SEQ + t) * 512 + hh * 64 + 4 * fq;
        float* op = (float*)(F.ws + AR_ORAW) + (size_t)(b * SEQ + t) * DM + 512 + hh * 64 + 4 * fq;
#pragma unroll
        for (int dt = 0; dt < 4; ++dt) *(f32x4*)(op + 16 * dt) = O[dt] * gc + *(const f32x4*)(ow + 16 * dt);
    }
    LDS_WAIT();
    const int cur = tb >> 6;
    if (cur <= 15) { if (z == 0 && fq == 0) { for (int j = 0; j <= cur; ++j) sel[tl * 16 + j] = (unsigned char)j; } }
    else {
        const int c16 = z + 4 * fq; float v[8];
#pragma unroll
        for (int i = 0; i < 8; ++i) { const int j = c16 * 8 + i; v[i] = (j >= 1 && j <= cur - 2) ? imp[tl * 132 + j] + imp[528 + tl * 132 + j] : -1.f; }
        if (c16 == 0) { sel[tl * 16 + 0] = 0; sel[tl * 16 + 14] = (unsigned char)cur; sel[tl * 16 + 15] = (unsigned char)(cur - 1); }
#pragma clang loop unroll(disable)
        for (int it = 0; it < 13; ++it) {
            float bv = v[0]; int bj = c16 * 8;
#pragma unroll
            for (int i = 1; i < 8; ++i) if (v[i] > bv) { bv = v[i]; bj = c16 * 8 + i; }
#pragma unroll
            for (int sh = 0; sh < 4; ++sh) { float ov; int oj;
                if (sh == 0) { ov = quad_x1(bv); oj = __float_as_int(quad_x1(__int_as_float(bj))); }
                else if (sh == 1) { ov = quad_x2(bv); oj = __float_as_int(quad_x2(__int_as_float(bj))); }
                else if (sh == 2) { ov = xor16f(bv); oj = __float_as_int(xor16f(__int_as_float(bj))); }
                else { ov = xor32f(bv); oj = __float_as_int(xor32f(__int_as_float(bj))); }
                if (ov > bv || (ov == bv && oj < bj)) { bv = ov; bj = oj; } }
#pragma unroll
            for (int i = 0; i < 8; ++i) if (c16 * 8 + i == bj) v[i] = -2.f;
            if (c16 == 0) sel[tl * 16 + 1 + it] = (unsigned char)bj;
        }
    }
    asm volatile("s_waitcnt vmcnt(0) lgkmcnt(0)" ::: "memory");
    LAS unsigned* msk = (LAS unsigned*)(F.lds + RING_OFF + F.wave * 8192 + 4288);
    LAS unsigned char* ulist = (LAS unsigned char*)(F.lds + RING_OFF + F.wave * 8192 + 4352);
    if (z == 0 && fq == 0) {
        unsigned w0 = 0u, w1 = 0u, w2 = 0u, w3 = 0u; const int n = cur <= 15 ? cur + 1 : 16;
        for (int i = 0; i < n; ++i) { const int j = sel[tl * 16 + i]; const unsigned bit = 1u << (j & 31);
            w0 |= (j >> 5) == 0 ? bit : 0u; w1 |= (j >> 5) == 1 ? bit : 0u; w2 |= (j >> 5) == 2 ? bit : 0u; w3 |= (j >> 5) == 3 ? bit : 0u; }
        msk[tl * 4 + 0] = w0; msk[tl * 4 + 1] = w1; msk[tl * 4 + 2] = w2; msk[tl * 4 + 3] = w3;
    }
    LDS_WAIT();
    const unsigned U0 = __builtin_amdgcn_readfirstlane(msk[0] | msk[4] | msk[8] | msk[12]), U1 = __builtin_amdgcn_readfirstlane(msk[1] | msk[5] | msk[9] | msk[13]);
    const unsigned U2 = __builtin_amdgcn_readfirstlane(msk[2] | msk[6] | msk[10] | msk[14]), U3 = __builtin_amdgcn_readfirstlane(msk[3] | msk[7] | msk[11] | msk[15]);
    const int c0n = __builtin_popcount(U0), c1n = __builtin_popcount(U1), c2n = __builtin_popcount(U2), nU = c0n + c1n + c2n + __builtin_popcount(U3);
    {   const int hi = F.lane >> 5, bb = F.lane & 31; const unsigned lowm = (1u << bb) - 1u;
        const unsigned wa = hi ? U1 : U0, wb = hi ? U3 : U2;
        if ((wa >> bb) & 1u) ulist[(hi ? c0n : 0) + __builtin_popcount(wa & lowm)] = (unsigned char)F.lane;
        if ((wb >> bb) & 1u) ulist[c0n + c1n + (hi ? c2n : 0) + __builtin_popcount(wb & lowm)] = (unsigned char)(64 + F.lane);
    }
    LDS_WAIT();
    const unsigned char* KS8 = (const unsigned char*)KS; const unsigned char* VS8 = (const unsigned char*)VST;
    long q8lo, q8hi;
    {   const u32x4 a = __builtin_bit_cast(u32x4, qf.lo), c = __builtin_bit_cast(u32x4, qf.hi);
        const unsigned l0 = cvt4_fp8(__uint_as_float(a.x << 16), __uint_as_float(a.x & 0xffff0000u), __uint_as_float(a.y << 16), __uint_as_float(a.y & 0xffff0000u));
        const unsigned l1 = cvt4_fp8(__uint_as_float(a.z << 16), __uint_as_float(a.z & 0xffff0000u), __uint_as_float(a.w << 16), __uint_as_float(a.w & 0xffff0000u));
        const unsigned h0 = cvt4_fp8(__uint_as_float(c.x << 16), __uint_as_float(c.x & 0xffff0000u), __uint_as_float(c.y << 16), __uint_as_float(c.y & 0xffff0000u));
        const unsigned h1 = cvt4_fp8(__uint_as_float(c.z << 16), __uint_as_float(c.z & 0xffff0000u), __uint_as_float(c.w << 16), __uint_as_float(c.w & 0xffff0000u));
        q8lo = (long)(((unsigned long long)l1 << 32) | l0); q8hi = (long)(((unsigned long long)h1 << 32) | h0); }
    struct SelStep { u32x4 k[2]; u32x4 v[2]; };
    const int l8 = fq * 256 + fr * 16;
#define SEL_LOADK(B, k0_) do { const int _k0 = (k0_); B.k[0] = *(const u32x4*)(KS8 + (size_t)(_k0 >> 4) * 1024 + l8); B.k[1] = *(const u32x4*)(KS8 + (size_t)((_k0 >> 4) + 1) * 1024 + l8); } while (0)
#define SEL_LOADV(V, k0_) do { const int _k0 = (k0_); V[0] = *(const u32x4*)(VS8 + (size_t)(_k0 >> 5) * 2048 + l8); V[1] = *(const u32x4*)(VS8 + (size_t)(_k0 >> 5) * 2048 + 1024 + l8); } while (0)
#define U2L(lo_, hi_) ((long)(((unsigned long long)(hi_) << 32) | (unsigned long long)(lo_)))
#define QK8(KK) __builtin_amdgcn_mfma_f32_16x16x32_fp8_fp8(U2L(KK.z, KK.w), q8hi, __builtin_amdgcn_mfma_f32_16x16x32_fp8_fp8(U2L(KK.x, KK.y), q8lo, (f32x4){0.f, 0.f, 0.f, 0.f}, 0, 0, 0), 0, 0, 0)
#define SEL_LOGITS(B, k0_, cv_, s0, s1) do { s0 = QK8(B.k[0]); s1 = QK8(B.k[1]); \
        if ((k0_) + 31 + 128 <= tb) { const float bb_ = (cv_) ? bfar : NEG_INF; _Pragma("unroll") for (int r = 0; r < 4; ++r) { s0[r] = s0[r] * QK_C + bb_; s1[r] = s1[r] * QK_C + bb_; } } \
        else { const int d0 = t - ((k0_) + 4 * fq); \
            _Pragma("unroll") for (int r = 0; r < 4; ++r) { const int da = d0 - r, db = d0 - 16 - r; \
                const int ia = da < 0 ? 0 : (da > 128 ? 128 : da), ib = db < 0 ? 0 : (db > 128 ? 128 : db); \
                s0[r] = ((cv_) && da >= 0) ? s0[r] * QK_C + bl[ia] : NEG_INF; s1[r] = ((cv_) && db >= 0) ? s1[r] * QK_C + bl[ib] : NEG_INF; } } } while (0)
#define SEL_K0(q_, ka_, kb_, va_, vb_) do { const int _p = (q_) >> 1, _h = (q_) & 1; const int _ja = __builtin_amdgcn_readfirstlane((int)ulist[2 * _p]); \
        const bool _hb = 2 * _p + 1 < nU; const int _jb = _hb ? __builtin_amdgcn_readfirstlane((int)ulist[2 * _p + 1]) : _ja; \
        ka_ = 64 * _ja + 32 * _h; kb_ = 64 * _jb + 32 * _h; va_ = ((msk[tl * 4 + (_ja >> 5)] >> (_ja & 31)) & 1u) != 0u; vb_ = _hb && (((msk[tl * 4 + (_jb >> 5)] >> (_jb & 31)) & 1u) != 0u); } while (0)
#define PV8(OO, VV, PP) do { OO[0] = __builtin_amdgcn_mfma_f32_16x16x32_fp8_fp8(U2L(VV[0].x, VV[0].y), PP, OO[0], 0, 0, 0); OO[1] = __builtin_amdgcn_mfma_f32_16x16x32_fp8_fp8(U2L(VV[0].z, VV[0].w), PP, OO[1], 0, 0, 0); \
        OO[2] = __builtin_amdgcn_mfma_f32_16x16x32_fp8_fp8(U2L(VV[1].x, VV[1].y), PP, OO[2], 0, 0, 0); OO[3] = __builtin_amdgcn_mfma_f32_16x16x32_fp8_fp8(U2L(VV[1].z, VV[1].w), PP, OO[3], 0, 0, 0); } while (0)
#define SEL_STEP(CA_, CB_, NA_, NB_, q_) do { int na0 = ka0, nb0 = kb0; bool nva = cva, nvb = cvb; if ((q_) + 1 < nstep) SEL_K0((q_) + 1, na0, nb0, nva, nvb); \
        SEL_LOADK(NA_, na0); SEL_LOADK(NB_, nb0); SEL_LOADV(NA_.v, na0); SEL_LOADV(NB_.v, nb0); \
        f32x4 sa0, sa1, sb0, sb1; SEL_LOGITS(CA_, ka0, cva, sa0, sa1); SEL_LOGITS(CB_, kb0, cvb, sb0, sb1); \
        const long pa = osm_step8(sa0, sa1, mA, lA, OA), pb = osm_step8(sb0, sb1, mB, lB, OB); \
        PV8(OA, CA_.v, pa); PV8(OB, CB_.v, pb); \
        ka0 = na0; kb0 = nb0; cva = nva; cvb = nvb; } while (0)
    {
        const int nstep = 2 * ((nU + 1) >> 1);
        float mA = NEG_INF, lA = 0.f, mB = NEG_INF, lB = 0.f; f32x4 OA[4], OB[4];
#pragma unroll
        for (int dt = 0; dt < 4; ++dt) { OA[dt] = (f32x4){0.f, 0.f, 0.f, 0.f}; OB[dt] = (f32x4){0.f, 0.f, 0.f, 0.f}; }
        SelStep XA, XB, YA, YB; int ka0, kb0; bool cva, cvb;
        SEL_K0(0, ka0, kb0, cva, cvb); SEL_LOADK(XA, ka0); SEL_LOADK(XB, kb0); SEL_LOADV(XA.v, ka0); SEL_LOADV(XB.v, kb0);
#pragma clang loop unroll(disable)
        for (int q = 0; q < nstep; q += 2) { SEL_STEP(XA, XB, YA, YB, q); SEL_STEP(YA, YB, XA, XB, q + 1); }
        const float mm = fmaxf(mA, mB), mu = (mm == NEG_INF) ? 0.f : mm, fa = __builtin_amdgcn_exp2f(mA - mu), fb = __builtin_amdgcn_exp2f(mB - mu);
        const float lt = fq_sum(lA * fa + lB * fb);
        const float sc = gates[(size_t)(b * SEQ + t) * 24 + hh * 3 + 1] / fmaxf(lt, 1e-30f);
        float* op = (float*)(F.ws + AR_ORAW) + (size_t)(b * SEQ + t) * DM + 512 + hh * 64 + 4 * fq;
#pragma unroll
        for (int dt = 0; dt < 4; ++dt) { const f32x4 prev = *(const f32x4*)(op + 16 * dt); *(f32x4*)(op + 16 * dt) = prev + (OA[dt] * fa + OB[dt] * fb) * sc; }
    }
#undef U2L
#undef QK8
#undef PV8
#undef SEL_LOADK
#undef SEL_LOADV
#undef SEL_LOGITS
#undef SEL_K0
#undef SEL_STEP
    LDS_WAIT();
}

constexpr int NPH_L = 9, NPHASES = 2 + 2 * NPH_L;

#define IN(k) (lo <= (k) && (k) < hi)
#if MK_SINGLE
#define SEAM(k) do { if (IN(k) && IN((k) + 1)) xcd_barrier(bar); } while (0)
#else
#define SEAM(k) do { } while (0)
#endif
template <int layer>
__device__ __forceinline__ void layer_body(Frame& F, const Args& args, const XcdBarrier& bar, const int lo, const int hi) {
        const int pb = 2 + layer * NPH_L;
#ifndef NO_GEMM
        if (IN(pb + 0)) {
            pg8::Gemm g{(const bf16*)(args.ws + WS_H), (const bf16*)(args.ws + WS_WIN) + (size_t)layer * NPROJ * DM, T, NPROJ, DM};
            pg8::StaticOrder S; S.init(T, NPROJ, F.G, (int)blockIdx.x);
            pg8::EpiProj E{(bf16*)(args.ws + AR_SBQ), (float*)(args.ws + AR_GATES)};
            pg8::gemm_phase<pg8::EpiProj, pg8::StaticOrder, true, 0>(F.lds + RING_OFF, g, nullptr, S, E);
        }
#endif
        SEAM(pb + 0);
        if (IN(pb + 1)) {
            if (F.vcu < 16) {
                pg8::Gemm g{(const bf16*)(args.ws + AR_NKV), (const bf16*)(args.ws + WS_CW1) + (size_t)layer * 2 * 256 * 2048, 4096, 512, 2048};
                pg8::CmpOrder S{F.G, F.vcu};
                pg8::EpiCmpHid E{(bf16*)(args.ws + AR_CHID), (const float*)(args.ws + WS_CBIAS) + (size_t)layer * 2 * 256};
                pg8::gemm_phase<pg8::EpiCmpHid, pg8::CmpOrder, false, 2>(F.lds + RING_OFF, g, nullptr, S, E);
                asm volatile("s_waitcnt vmcnt(0)" ::: "memory"); __syncthreads();
                cmp_out_unit(F, layer, F.vcu);
            }
#ifndef NO_WIN
            if (F.G == 256) {
                const int wv = F.vcu * NWAVES + F.wave;
                if (wv < 128) win_task(F, ((wv >> 5) << 9) | (wv & 31));
                else { const int r = wv - 128; win_task(F, ((r / 480) << 9) | (32 + r % 480)); }
            } else { for (int task = F.vcu * NWAVES + F.wave; task < 2048; task += F.G * NWAVES) win_task(F, task); }
#endif
#ifndef NO_SB
            if (F.vcu >= 16) { for (int task = (F.vcu - 16) * NWAVES + F.wave; task < 8192; task += (F.G - 16) * NWAVES) sb_task(F, task); }
#endif
        }
        SEAM(pb + 1);
#ifndef NO_NSA
        if (IN(pb + 2)) {
            unsigned* qh = (unsigned*)(args.ws + WS_CTL) + CW_QUEUE + layer * 64;
            for (;;) {
                unsigned q = 0; if (F.lane == 0) q = __hip_atomic_fetch_add(qh, 1u, __ATOMIC_RELAXED, __HIP_MEMORY_SCOPE_AGENT);
                q = __builtin_amdgcn_readfirstlane(q);
                if (q >= 8192u) break;
                nsa_task(F, (int)q);
            }
        }
#endif
        SEAM(pb + 2);
        if (IN(pb + 3)) { phase_merge(F, layer); }
        SEAM(pb + 3);
#ifndef NO_GEMM
        if (IN(pb + 4)) {
            pg8::Gemm g{(const bf16*)(args.ws + WS_H), (const bf16*)(args.ws + WS_WOUT) + (size_t)layer * DM * DM, T, DM, DM};
            pg8::StaticOrder S; S.init(T, DM, F.G, (int)blockIdx.x);
            pg8::EpiOutBf16 E{(bf16*)(args.ws + AR_M), DM};
            pg8::gemm_phase<pg8::EpiOutBf16, pg8::StaticOrder, false, 0>(F.lds + RING_OFF, g, nullptr, S, E);
        }
#endif
        SEAM(pb + 4);
#ifndef NO_THIN
        if (IN(pb + 5)) { phase_post_mix(F, layer); }
#endif
        SEAM(pb + 5);
#ifndef NO_GEMM
        if (IN(pb + 6)) {
            if (layer == 0) {
                pg8::Gemm g{(const bf16*)(args.ws + WS_H), (const bf16*)(args.ws + WS_FGU), T, 2 * DFF, DM};
                pg8::StaticOrder S; S.init(T, 2 * DFF, F.G, (int)blockIdx.x);
                pg8::EpiSwiglu E{(bf16*)(args.ws + AR_FHID), DFF, DFF / 128};
                pg8::gemm_phase<pg8::EpiSwiglu, pg8::StaticOrder, true, 0>(F.lds + RING_OFF, g, nullptr, S, E);
            } else {
                moe_table_build(F); const LAS int* tbl = (const LAS int*)(F.lds + MOETBL_OFF);
#define NTL(e) __builtin_amdgcn_readfirstlane(tbl[16 + (e)])
#define CNL(e) __builtin_amdgcn_readfirstlane(tbl[8 + (e)])
                pg8::Gemm g{(const bf16*)(args.ws + WS_H), (const bf16*)(args.ws + WS_MGU), MOE_ROWS, NE * 2 * DFE, DM};
                pg8::MoeOrder S{NTL(0), NTL(1), NTL(2), NTL(3), NTL(4), NTL(5), NTL(6), NTL(7), 2 * DFE / 256, F.G, (int)blockIdx.x, CNL(0), CNL(1), CNL(2), CNL(3), CNL(4), CNL(5), CNL(6), CNL(7)};
                pg8::EpiSwiglu E{(bf16*)(args.ws + AR_HIDM), DFE, DFE / 128};
                pg8::gemm_phase<pg8::EpiSwiglu, pg8::MoeOrder, true, 1>(F.lds + RING_OFF, g, (const int*)(args.ws + AR_ROWTOK), S, E);
            }
        }
#endif
        SEAM(pb + 6);
#ifndef NO_GEMM
        if (IN(pb + 7)) {
            if (layer == 0) {
                pg8::Gemm g{(const bf16*)(args.ws + AR_FHID), (const bf16*)(args.ws + WS_FD), T, DM, DFF};
                pg8::StaticOrder S; S.init(T, DM, F.G, (int)blockIdx.x);
                pg8::EpiOutBf16 E{(bf16*)(args.ws + AR_FOUT), DM};
                pg8::gemm_phase<pg8::EpiOutBf16, pg8::StaticOrder, false, 0>(F.lds + RING_OFF, g, nullptr, S, E);
            } else {
                moe_table_build(F); const LAS int* tbl = (const LAS int*)(F.lds + MOETBL_OFF);
                pg8::Gemm g{(const bf16*)(args.ws + AR_HIDM), (const bf16*)(args.ws + WS_MD), MOE_ROWS, NE * DM, DFE};
                const int nfull = __builtin_amdgcn_readfirstlane(tbl[24]), nS = __builtin_amdgcn_readfirstlane(tbl[25]);
                pg8::MoeDownOrder S{NTL(0), NTL(1), NTL(2), NTL(3), NTL(4), NTL(5), NTL(6), NTL(7), DM / 256, F.G, (int)blockIdx.x, nfull, nS, DFE / 64};
                pg8::EpiMoeDown E{(bf16*)(args.ws + WS_Y), (bf16*)(args.ws + WS_YPART), nfull * 256};
                pg8::gemm_phase<pg8::EpiMoeDown, pg8::MoeDownOrder, true, 0>(F.lds + RING_OFF, g, nullptr, S, E);
            }
        }
#endif
        SEAM(pb + 7);
#ifndef NO_THIN
        if (IN(pb + 8)) { phase_post_ffn(F, layer); }
#endif
        SEAM(pb + 8);

}
__global__ void __launch_bounds__(NTHR, 2) mega(Args args) {
    extern __shared__ __attribute__((aligned(16))) unsigned char lds_raw[];
    Frame F;
    F.lds = (LAS unsigned char*)lds_raw; F.a = &args; F.ws = args.ws;
    F.tid = threadIdx.x; F.lane = F.tid & 63; F.wave = __builtin_amdgcn_readfirstlane(F.tid >> 6);
    F.G = gridDim.x; { const int bx = blockIdx.x; F.vcu = (F.G % 8 == 0) ? (bx % 8) * (F.G / 8) + bx / 8 : bx; }
    if (F.tid < 4) ((LAS unsigned*)(F.lds + LDSCTL_OFF))[F.tid] = 0u;
    if (F.tid < 128) { const int n = F.tid; int bk = n;
        if (n >= 16) { bk = 16 + (int)(__log2f((float)n * (1.f / 16.f)) * (16.f / 3.f)); bk = bk > 31 ? 31 : bk; }
        ((LAS unsigned char*)(F.lds + LDSCTL_OFF + 64))[n] = (unsigned char)bk; }
    if (F.tid < 256) ((LAS float*)(F.lds + LDSCTL_OFF + 256))[F.tid] = args.in[2][F.tid];
    __syncthreads();
    for (int i = F.tid; i < 8 * 132; i += NTHR) { const int hh = i / 132, d = i % 132; const int bk = d < 128 ? (int)((LAS unsigned char*)(F.lds + LDSCTL_OFF + 64))[d] : 31;
        ((LAS float*)(F.lds + BIASL_OFF))[i] = ((LAS float*)(F.lds + LDSCTL_OFF + 256))[bk * 8 + hh] * 1.4426950408889634f; }
    __syncthreads();
    unsigned* ctl = (unsigned*)(args.ws + WS_CTL);
#if MK_SINGLE
    XcdBarrier bar = xcd_barrier_post(ctl + CW_BAR, (volatile LAS unsigned*)(F.lds + LDSCTL_OFF));
#else
    XcdBarrier bar; bar.bar = ctl; bar.x = 0; bar.st = nullptr;
#endif
    const int lo = args.ph_lo, hi = args.ph_hi;
#ifndef NO_PRO
    if (IN(0)) { phase_prologue(F); }
#endif
    SEAM(0);
    if (IN(1)) { phase_h0(F); } SEAM(1);
    layer_body<0>(F, args, bar, lo, hi);
    layer_body<1>(F, args, bar, lo, hi);
#undef IN
#undef SEAM
}


extern "C" void kernel_launch(void* const* d_in, const int* in_sizes, int n_in, void* d_out, int out_size, void* d_ws, size_t ws_size, hipStream_t stream) {
    static int grid = 0;
    if (grid == 0) {
        if (n_in != 27 || out_size != T * DM || ws_size < WS_END) { fprintf(stderr, "kernel_launch: unexpected problem (n_in %d out %d ws %zu)\n", n_in, out_size, ws_size); grid = -1; return; }
        int dev = 0, cus = 0, per_cu = 0;
        if (hipGetDevice(&dev) != hipSuccess || hipDeviceGetAttribute(&cus, hipDeviceAttributeMultiprocessorCount, dev) != hipSuccess) { grid = -1; return; }
        if (hipFuncSetAttribute((const void*)mega, hipFuncAttributeMaxDynamicSharedMemorySize, LDS_BYTES) != hipSuccess) { fprintf(stderr, "kernel_launch: hipFuncSetAttribute failed\n"); grid = -1; return; }
        if (hipOccupancyMaxActiveBlocksPerMultiprocessor(&per_cu, (const void*)mega, NTHR, LDS_BYTES) != hipSuccess || per_cu < 1) { fprintf(stderr, "kernel_launch: occupancy query says %d\n", per_cu); }
        (void)hipGetLastError();
        grid = cus;
    }
    if (grid < 0) return;
    if (hipMemsetAsync((char*)d_ws + WS_CTL, 0, CTL_ZERO_BYTES, stream) != hipSuccess) return;
    Args a{};
    for (int i = 0; i < 27; ++i) a.in[i] = (const float*)d_in[i];
    a.out = (float*)d_out; a.ws = (unsigned char*)d_ws;
#if MK_SINGLE
    a.ph_lo = 0; a.ph_hi = NPHASES;
    hipLaunchKernelGGL(mega, dim3(grid), dim3(NTHR), LDS_BYTES, stream, a);
#else
#ifndef MK_MAXPH
#define MK_MAXPH NPHASES
#endif
    for (int p = 0; p < MK_MAXPH; ++p) {
        a.ph_lo = p; a.ph_hi = p + 1;
        hipLaunchKernelGGL(mega, dim3(grid), dim3(NTHR), LDS_BYTES, stream, a);
    }
#endif
}
```

```cpp
#include <hip/hip_runtime.h>
#include <cstdint>
#include <cstdio>

#define GAS __attribute__((address_space(1)))
#define LAS __attribute__((address_space(3)))
typedef unsigned short bf16;
typedef short bf16x8 __attribute__((ext_vector_type(8)));
typedef float f32x4 __attribute__((ext_vector_type(4)));
typedef unsigned u32x4 __attribute__((ext_vector_type(4)));
typedef unsigned u32x2 __attribute__((ext_vector_type(2)));
typedef __bf16 bf16x2_t __attribute__((ext_vector_type(2)));

#ifndef MK_SINGLE
#define MK_SINGLE 1
#endif

constexpr int NB = 2, SEQ = 8192, T = NB * SEQ, DM = 1024, DH = 64;
constexpr int IN_COLS = 2840, NPROJ = 3072;
constexpr int NCMP = 511;
constexpr int DFF = 2816, DFE = 3584, NE = 8;
constexpr int MOE_ROWS = 34816;
constexpr float EPS = 1e-6f;
constexpr int NWAVES = 8, NTHR = 512;

constexpr size_t MiB = 1u << 20;
constexpr size_t WS_CTL = 0, CTL_ZERO_BYTES = 65536;
constexpr size_t WS_WIN = 1 * MiB;
constexpr size_t WS_WOUT = 13 * MiB;
constexpr size_t WS_CW1 = 17 * MiB;
constexpr size_t WS_CW2 = 21 * MiB;
constexpr size_t WS_CBIAS = 21 * MiB + 131072;
constexpr size_t WS_MOD = 524288;
constexpr size_t WS_FGU = 22 * MiB;
constexpr size_t WS_FD = 33 * MiB;
constexpr size_t WS_MGU = 39 * MiB;
constexpr size_t WS_MD = 151 * MiB;
constexpr size_t WS_H = 207 * MiB;
constexpr size_t WS_AR = 239 * MiB;
constexpr size_t AR_SBQ = WS_AR, AR_SBK = WS_AR + 16 * MiB, AR_SBV = WS_AR + 32 * MiB, AR_NQ = WS_AR + 48 * MiB, AR_NKV = WS_AR + 64 * MiB;
constexpr size_t AR_GATES = WS_AR + 88 * MiB, AR_KC = WS_AR + 90 * MiB, AR_ORAW = WS_AR + 92 * MiB, AR_OWIN = WS_AR + 156 * MiB;
constexpr size_t AR_CHID = WS_AR + 188 * MiB;
constexpr size_t AR_M = WS_AR;
constexpr size_t AR_FHID = WS_AR + 64 * MiB, AR_FOUT = WS_AR + 152 * MiB;
constexpr size_t AR_HIDM = WS_AR, AR_TOKINFO = WS_AR + 240 * MiB, AR_ROWTOK = WS_AR + 241 * MiB;
constexpr size_t WS_Y = 1 * MiB;
constexpr size_t WS_END = WS_AR + 242 * MiB;
constexpr size_t WS_YPART = 72 * MiB;
static_assert(WS_Y + (size_t)MOE_ROWS * 1024 * 4 <= WS_MD, "y overlay");
static_assert(WS_Y + (size_t)MOE_ROWS * 1024 * 2 <= WS_YPART && WS_YPART + (size_t)7 * 2048 * 1024 * 2 <= WS_MD, "y partials overlay");
static_assert(AR_HIDM + (size_t)MOE_ROWS * DFE * 2 <= AR_TOKINFO, "moe hidden");

constexpr int CW_BAR = 4096, CW_CNT = 8192, CW_QUEUE = 8448;

constexpr int RING_OFF = 0, RING_BYTES = 131072;
constexpr int LDSCTL_OFF = RING_BYTES;
constexpr int BIASL_OFF = LDSCTL_OFF + 1536;
constexpr int LDS_BYTES = 147456;

struct Args { const float* in[27]; float* out; unsigned char* ws; int ph_lo, ph_hi; };

typedef float f32x2_t __attribute__((ext_vector_type(2)));
__device__ __forceinline__ unsigned cvt_pk_bf16(float lo, float hi) { const f32x2_t v = {lo, hi}; const bf16x2_t b = __builtin_convertvector(v, bf16x2_t); return __builtin_bit_cast(unsigned, b); }
__device__ __forceinline__ float wave_sum(float v) {
    v += __uint_as_float(__builtin_amdgcn_update_dpp(0, __float_as_uint(v), 0xB1, 0xf, 0xf, true));
    v += __uint_as_float(__builtin_amdgcn_update_dpp(0, __float_as_uint(v), 0x4E, 0xf, 0xf, true));
    v += __uint_as_float(__builtin_amdgcn_update_dpp(0, __float_as_uint(v), 0x141, 0xf, 0xf, true));
    v += __uint_as_float(__builtin_amdgcn_update_dpp(0, __float_as_uint(v), 0x140, 0xf, 0xf, true));
    auto a = __builtin_amdgcn_permlane16_swap(__float_as_uint(v), __float_as_uint(v), false, false); v = __uint_as_float(a[0]) + __uint_as_float(a[1]);
    auto b = __builtin_amdgcn_permlane32_swap(__float_as_uint(v), __float_as_uint(v), false, false); return __uint_as_float(b[0]) + __uint_as_float(b[1]);
}


__host__ __device__ __forceinline__ size_t koff(int s, int d) { return (size_t)(s >> 4) * 1024 + (size_t)((d >> 5) * 512 + ((d >> 3) & 3) * 128 + (s & 15) * 8 + (d & 7)); }
__host__ __device__ __forceinline__ size_t voff(int s, int d) { return (size_t)(s >> 5) * 2048 + (size_t)((d >> 4) * 512 + ((s & 15) >> 2) * 128 + (d & 15) * 8 + ((s >> 4) & 1) * 4 + (s & 3)); }

__host__ __device__ __forceinline__ size_t k8off(int s, int d) { return (size_t)(s >> 4) * 1024 + (size_t)(((d >> 3) & 3) * 256 + (s & 15) * 16 + (d >> 5) * 8 + (d & 7)); }
__host__ __device__ __forceinline__ size_t v8off(int s, int d) { return (size_t)(s >> 5) * 2048 + (size_t)((d >> 5) * 1024 + ((s & 15) >> 2) * 256 + (d & 15) * 16 + ((d >> 4) & 1) * 8 + ((s >> 4) & 1) * 4 + (s & 3)); }
__device__ __forceinline__ unsigned cvt4_fp8(float a, float b, float c, float d) { int w = __builtin_amdgcn_cvt_pk_fp8_f32(a, b, 0, false); w = __builtin_amdgcn_cvt_pk_fp8_f32(c, d, w, true); return (unsigned)w; }

namespace pg8 {
constexpr int BM = 256, BK = 64, HALF = 128, HTB = HALF * BK * 2, NXCD = 8, WGM = 8;
__host__ __device__ __forceinline__ int lds_byte(int r, int c) { const int st = (r >> 4) * 2 + (c >> 5), rr = r & 15, cc = c & 31, ob = rr * 64 + cc * 2; return st * 1024 + (ob ^ (((ob >> 9) & 1) << 5)); }
__host__ __device__ __forceinline__ void stage_rc(int b, int& R, int& C) { const int st = b / 1024, sb = b % 1024, swz = sb ^ (((sb >> 9) & 1) << 5); R = (st >> 1) * 16 + swz / 64; C = (st & 1) * 32 + (swz % 64) / 2; }
__host__ __device__ __forceinline__ int perm32(int rho) { const int n = rho >> 4, i = rho & 15; return 8 * (i >> 2) + 4 * n + (i & 3); }
struct Unit { int pm, pn, ga, gl, k0, nt, part, sw; };
struct Gemm { const bf16* A; const bf16* Bt; int M, N, K; };
struct StaticOrder {
    static constexpr bool SPLIT = false;
    int nM, nN, nwg, G, c;
    __device__ void init(int M, int N, int G_, int c_) { nM = M / BM; nN = N / BM; nwg = nM * nN; G = G_; c = c_; }
    __device__ bool next(int i, Unit& u) const {
        const long L = (long)i * G + c; if (L >= nwg) return false;
        int wgid = (int)L; { const int q = nwg / NXCD, r = nwg % NXCD, xcd = wgid % NXCD, off = wgid / NXCD; wgid = (xcd < r ? xcd * (q + 1) : r * (q + 1) + (xcd - r) * q) + off; }
        const int nig = WGM * nN, gid = wgid / nig, fm = gid * WGM, gsz = (nM - fm) < WGM ? (nM - fm) : WGM;
        u.pm = fm + ((wgid % nig) % gsz); u.pn = (wgid % nig) / gsz; u.ga = 0; u.gl = 0; u.sw = 0; return true;
    }
};
struct ProjOrder : StaticOrder {
    __device__ bool next(int i, Unit& u) const { if (!StaticOrder::next(i, u)) return false; u.sw = (u.pn == 4 || u.pn == 5) ? 3 : ((u.pn == 9 || u.pn == 10) ? 2 : 0); return true; }
};
struct MoeOrder {
    static constexpr bool SPLIT = false;
    int nt0, nt1, nt2, nt3, nt4, nt5, nt6, nt7; int nN, G, c; int cn0, cn1, cn2, cn3, cn4, cn5, cn6, cn7;
    __device__ bool next(int i, Unit& u) const {
        int L = i * G + c; int tb = 0; bool found = false;
#define MOE_STEP(e, nte) if (!found) { const int ue = nte * nN; if (L < ue) { u.pm = tb + L % nte; u.pn = e * nN + L / nte; u.ga = e * 16384 - tb * 256; u.gl = tb * 256 + cn##e; found = true; } else { L -= ue; tb += nte; } }
        MOE_STEP(0, nt0) MOE_STEP(1, nt1) MOE_STEP(2, nt2) MOE_STEP(3, nt3) MOE_STEP(4, nt4) MOE_STEP(5, nt5) MOE_STEP(6, nt6) MOE_STEP(7, nt7)
#undef MOE_STEP
        return found;
    }
};

struct MoeDownOrder {
    static constexpr bool SPLIT = true;
    int nt0, nt1, nt2, nt3, nt4, nt5, nt6, nt7; int nN, G, c, nfull, S, ntk;
    __device__ bool next(int i, Unit& u) const {
        int L = i * G + c; int tb = 0; bool found = false;
#define MOE_STEP(e, nte) if (!found) { int fe = nfull - tb; fe = fe < 0 ? 0 : (fe > nte ? nte : fe); const int ue = fe * nN; if (L < ue) { u.pm = tb + L % fe; u.pn = e * nN + L / fe; found = true; } else { L -= ue; tb += nte; } }
        MOE_STEP(0, nt0) MOE_STEP(1, nt1) MOE_STEP(2, nt2) MOE_STEP(3, nt3) MOE_STEP(4, nt4) MOE_STEP(5, nt5) MOE_STEP(6, nt6) MOE_STEP(7, nt7)
#undef MOE_STEP
        u.ga = 0; u.gl = 0; u.k0 = 0; u.nt = ntk; u.part = -1;
        if (found) return true;
        const int ntail = tb - nfull;
        if (S <= 1 || L >= ntail * nN * S) return false;
        const int s = L % S, j = L / S, tile = nfull + j % ntail, pnl = j / ntail;
        int e = 0, te = nt0;
#define MOE_FIND(nte) if (tile >= te) { ++e; te += nte; }
        MOE_FIND(nt1) MOE_FIND(nt2) MOE_FIND(nt3) MOE_FIND(nt4) MOE_FIND(nt5) MOE_FIND(nt6) MOE_FIND(nt7)
#undef MOE_FIND
        u.pm = tile; u.pn = e * nN + pnl; u.nt = ntk / S; u.k0 = s * (ntk / S) * (BK * 2); u.part = s;
        return true;
    }
};

template <class Epi, class Sched, bool ALIGN_EPI, int GATHER, bool SWAPV = false>
__device__ __forceinline__ void gemm_phase(LAS unsigned char* lds, const Gemm g, const int* rowidx, const Sched& S, const Epi& E) {
    const int tid = threadIdx.x, wid = __builtin_amdgcn_readfirstlane(tid >> 6), lane = tid & 63, wr = wid >> 2, wc = wid & 3, fr = lane & 15, fq = lane >> 4;
    const int K = g.K, nt = K / BK;
    int RA[2]; unsigned CA2[2], voffB[2];
#pragma unroll
    for (int i = 0; i < 2; ++i) { int R, C; stage_rc(tid * 16 + i * 8192, R, C); const int Rb = (R & ~31) + perm32(R & 31);
        RA[i] = R; CA2[i] = (unsigned)C * 2u; voffB[i] = (unsigned)(Rb * K + C) * 2u; }
    const unsigned rowbytes = GATHER == 2 ? 2048u : (unsigned)K * 2u;
    const size_t kstep = (size_t)(BK * 2);
    const size_t hstep = (size_t)HALF * K * 2;
    const size_t tstep = 2 * hstep;
    const unsigned ldsw = (unsigned)wid * 1024u;
    const int aoff = lds_byte(wr * 64 + fr, fq * 8), boff = lds_byte(wc * 32 + fr, fq * 8);
    const char* Abase = (const char*)g.A;
#define PG8_SA(b, h) (((b) * 2 + (h)) * HTB)
#define PG8_SB(b, h) ((4 + (b) * 2 + (h)) * HTB)
#define PG8_STAGE_B(bufoff, gbase) do { _Pragma("unroll") for (int _i = 0; _i < 2; ++_i) \
        __builtin_amdgcn_global_load_lds((const unsigned*)((const char*)(gbase) + voffB[_i]), (LAS unsigned*)(lds + (bufoff) + ldsw + _i * 8192), 16, 0, 0); } while (0)
#define PG8_STAGE_A(bufoff, GG, h, kb) do { _Pragma("unroll") for (int _i = 0; _i < 2; ++_i) \
        __builtin_amdgcn_global_load_lds((const unsigned*)(Abase + (size_t)(kb) + (size_t)GG[h][_i]), (LAS unsigned*)(lds + (bufoff) + ldsw + _i * 8192), 16, 0, 0); } while (0)
#define PG8_CALC_G(U_, GG) do { _Pragma("unroll") for (int _h = 0; _h < 2; ++_h) _Pragma("unroll") for (int _i = 0; _i < 2; ++_i) { \
        int _row = (U_).pm * BM + _h * HALF + RA[_i]; if (GATHER == 1) _row = _row < (U_).gl ? rowidx[_row + (U_).ga] : 0; if (GATHER == 2) { const int _n = _row & 511; _row = (_row & ~511) | (_n > 510 ? 510 : _n); } GG[_h][_i] = (unsigned)_row * rowbytes + CA2[_i] + (Sched::SPLIT ? (unsigned)(U_).k0 : 0u); } } while (0)
#define PG8_LDA(dst, b, h) do { _Pragma("unroll") for (int m = 0; m < 4; ++m) _Pragma("unroll") for (int k = 0; k < 2; ++k) dst[m][k] = *(const LAS bf16x8*)(lds + PG8_SA(b, h) + aoff + m * 2048 + k * 1024); } while (0)
#define PG8_LDB(dst, b, h) do { _Pragma("unroll") for (int n = 0; n < 2; ++n) _Pragma("unroll") for (int k = 0; k < 2; ++k) dst[n][k] = *(const LAS bf16x8*)(lds + PG8_SB(b, h) + boff + n * 2048 + k * 1024); } while (0)
#define PG8_MMA(ai, bj, At, Bt) do { __builtin_amdgcn_s_setprio(1); \
        if (SWAPV && (((SWC_) >> (bj)) & 1)) { _Pragma("unroll") for (int m = 0; m < 4; ++m) _Pragma("unroll") for (int n = 0; n < 2; ++n) _Pragma("unroll") for (int k = 0; k < 2; ++k) \
            acc[ai][bj][m][n] = __builtin_amdgcn_mfma_f32_16x16x32_bf16(At[m][k], Bt[n][k], acc[ai][bj][m][n], 0, 0, 0); } \
        else { _Pragma("unroll") for (int m = 0; m < 4; ++m) _Pragma("unroll") for (int n = 0; n < 2; ++n) _Pragma("unroll") for (int k = 0; k < 2; ++k) \
            acc[ai][bj][m][n] = __builtin_amdgcn_mfma_f32_16x16x32_bf16(Bt[n][k], At[m][k], acc[ai][bj][m][n], 0, 0, 0); } \
        __builtin_amdgcn_s_setprio(0); } while (0)
#define PG8_WAIT_V(n) asm volatile("s_waitcnt vmcnt(" #n ")" ::: "memory")
#define PG8_WAIT_L(n) asm volatile("s_waitcnt lgkmcnt(" #n ")" ::: "memory")
#define PG8_BAR __builtin_amdgcn_s_barrier()
#define PG8_SCHED __builtin_amdgcn_sched_barrier(0)
#define PG8_KLOOP() \
        for (int t = 0; t < cnt; t += 2) { \
            const bool last = (t == cnt - 2); \
            const size_t kb1 = (size_t)(t + 1) * kstep; \
            unsigned g2[2][2]; \
_Pragma("unroll") \
            for (int h = 0; h < 2; ++h) \
_Pragma("unroll") \
                for (int i = 0; i < 2; ++i) g2[h][i] = last ? gn[h][i] : gc[h][i]; \
            const size_t kb2 = last ? (size_t)0 : (size_t)(t + 2) * kstep, kb3 = kb2 + kstep; \
            const char* b2 = last ? nB : cB + (size_t)(t + 2) * kstep; const char* b3 = b2 + kstep; \
            PG8_LDB(B0, 0, 0); PG8_LDB(B1, 0, 1); PG8_SCHED; PG8_LDA(At, 0, 0); PG8_STAGE_A(PG8_SA(1, 1), gc, 1, kb1); \
            PG8_WAIT_V(8); PG8_WAIT_L(0); PG8_BAR; PG8_MMA(0, 0, At, B0); PG8_MMA(0, 1, At, B1); PG8_BAR; PG8_SCHED; \
            PG8_LDA(At, 0, 1); PG8_STAGE_B(PG8_SB(0, 0), b2); PG8_STAGE_B(PG8_SB(0, 1), b2 + hstep); PG8_STAGE_A(PG8_SA(0, 0), g2, 0, kb2); \
            PG8_WAIT_V(8); PG8_WAIT_L(0); PG8_BAR; PG8_MMA(1, 0, At, B0); PG8_MMA(1, 1, At, B1); PG8_BAR; PG8_SCHED; \
            PG8_LDB(B0, 1, 0); PG8_LDB(B1, 1, 1); PG8_SCHED; PG8_LDA(At, 1, 0); PG8_STAGE_A(PG8_SA(0, 1), g2, 1, kb2); \
            PG8_WAIT_V(8); PG8_WAIT_L(0); PG8_BAR; PG8_MMA(0, 0, At, B0); PG8_MMA(0, 1, At, B1); PG8_BAR; PG8_SCHED; \
            PG8_LDA(At, 1, 1); PG8_STAGE_B(PG8_SB(1, 0), b3); PG8_STAGE_B(PG8_SB(1, 1), b3 + hstep); PG8_STAGE_A(PG8_SA(1, 0), g2, 0, kb3); \
            PG8_WAIT_V(8); PG8_WAIT_L(0); PG8_BAR; PG8_MMA(1, 0, At, B0); PG8_MMA(1, 1, At, B1); PG8_BAR; PG8_SCHED; \
        }
    Unit cur, nxt; int ui = 0;
    if (!S.next(0, cur)) return;
    f32x4 acc[2][2][4][2];
#pragma unroll
    for (int a = 0; a < 2; ++a)
#pragma unroll
        for (int b = 0; b < 2; ++b)
#pragma unroll
            for (int m = 0; m < 4; ++m)
#pragma unroll
                for (int n = 0; n < 2; ++n) acc[a][b][m][n] = (f32x4){0.f, 0.f, 0.f, 0.f};
    bf16x8 At[4][2], B0[2][2], B1[2][2];
    unsigned gc[2][2], gn[2][2];
    PG8_CALC_G(cur, gc);
    const char* cB = (const char*)g.Bt + (size_t)cur.pn * tstep + (Sched::SPLIT ? (size_t)cur.k0 : (size_t)0);
    PG8_STAGE_B(PG8_SB(0, 0), cB); PG8_STAGE_B(PG8_SB(0, 1), cB + hstep); PG8_STAGE_A(PG8_SA(0, 0), gc, 0, 0); PG8_STAGE_A(PG8_SA(0, 1), gc, 1, 0);
    if (wr == 1) PG8_BAR;
    PG8_WAIT_V(2); PG8_BAR;
    PG8_STAGE_B(PG8_SB(1, 0), cB + kstep); PG8_STAGE_A(PG8_SA(1, 0), gc, 0, kstep); PG8_STAGE_B(PG8_SB(1, 1), cB + hstep + kstep);
    PG8_WAIT_V(6); PG8_BAR;
    for (;;) {
        const bool has_next = S.next(ui + 1, nxt);
        if (has_next) { PG8_CALC_G(nxt, gn); }
        else {
#pragma unroll
            for (int h = 0; h < 2; ++h)
#pragma unroll
                for (int i = 0; i < 2; ++i) gn[h][i] = gc[h][i];
        }
        const char* nB = has_next ? (const char*)g.Bt + (size_t)nxt.pn * tstep + (Sched::SPLIT ? (size_t)nxt.k0 : (size_t)0) : cB;
        const int cnt = Sched::SPLIT ? cur.nt : nt;
        const int csw = SWAPV ? cur.sw : 0;
        if constexpr (SWAPV) {
            if (csw == 3) {
#define SWC_ 3
                PG8_KLOOP()
#undef SWC_
            } else if (csw == 2) {
#define SWC_ 2
                PG8_KLOOP()
#undef SWC_
            } else {
#define SWC_ 0
                PG8_KLOOP()
#undef SWC_
            }
        } else {
#define SWC_ 0
            PG8_KLOOP()
#undef SWC_
        }
        if constexpr (ALIGN_EPI) { if (wr == 0) PG8_BAR; }
        E(acc, cur, wr, wc, fr, fq);
        if (!has_next) break;
#pragma unroll
        for (int a = 0; a < 2; ++a)
#pragma unroll
            for (int b = 0; b < 2; ++b)
#pragma unroll
                for (int m = 0; m < 4; ++m)
#pragma unroll
                    for (int n = 0; n < 2; ++n) acc[a][b][m][n] = (f32x4){0.f, 0.f, 0.f, 0.f};
        cur = nxt; cB = nB; ++ui;
#pragma unroll
        for (int h = 0; h < 2; ++h)
#pragma unroll
            for (int i = 0; i < 2; ++i) gc[h][i] = gn[h][i];
        if constexpr (ALIGN_EPI) { if (wr == 1) PG8_BAR; }
    }
    PG8_WAIT_V(0);
    if constexpr (!ALIGN_EPI) { if (wr == 0) PG8_BAR; }
    PG8_BAR;
#undef PG8_SA
#undef PG8_SB
#undef PG8_STAGE_A
#undef PG8_STAGE_B
#undef PG8_CALC_G
#undef PG8_LDA
#undef PG8_LDB
#undef PG8_MMA
#undef PG8_KLOOP
#undef PG8_WAIT_V
#undef PG8_WAIT_L
#undef PG8_BAR
#undef PG8_SCHED
}

struct EpiProj {
    bf16* base; float* gates;
    __device__ __forceinline__ void operator()(const f32x4 (&acc)[2][2][4][2], const Unit& u, int wr, int wc, int fr, int fq) const {
#pragma unroll
        for (int ai = 0; ai < 2; ++ai)
#pragma unroll
            for (int m = 0; m < 4; ++m) {
                const int row = u.pm * BM + ai * HALF + wr * 64 + m * 16 + fr, b = row >> 13, s = row & 8191;
#pragma unroll
                for (int bj = 0; bj < 2; ++bj) {
                    if ((u.sw >> bj) & 1) {
                        if (m & 1) continue;
                        const int rowb = u.pm * BM + ai * HALF + wr * 64 + m * 16 + 4 * fq, b2 = rowb >> 13, s2 = rowb & 8191;
                        int frx = fr; asm volatile("" : "+v"(frx));
#pragma unroll
                        for (int n = 0; n < 2; ++n) {
                            const int c = u.pn * BM + bj * HALF + wc * 32 + 8 * (frx >> 2) + 4 * n + (frx & 3), d = c & 63;
                            const f32x4 e0 = acc[ai][bj][m][n], e1 = acc[ai][bj][m + 1][n];
                            if (c < 2048) { const int h = (c & 511) >> 6;
                                u32x4 w; w.x = cvt_pk_bf16(e0[0], e0[1]); w.y = cvt_pk_bf16(e0[2], e0[3]); w.z = cvt_pk_bf16(e1[0], e1[1]); w.w = cvt_pk_bf16(e1[2], e1[3]);
                                *(u32x4*)(base + (size_t)2 * 8388608u + (size_t)(b2 * 8 + h) * SEQ * 64 + voff(s2, d)) = w;
                            } else { const int idx = c - 2048, br = idx >> 8, gg = (idx >> 6) & 1; const size_t tb2 = (size_t)4 * 8388608u + (size_t)(((br * 2 + 1) * 2 + b2) * 2 + gg) * SEQ * 64;
                                if (br == 1) { u32x2 q; q.x = cvt4_fp8(e0[0], e0[1], e0[2], e0[3]); q.y = cvt4_fp8(e1[0], e1[1], e1[2], e1[3]); *(u32x2*)((unsigned char*)(base + tb2) + v8off(s2, d)) = q; }
                                else { u32x4 w; w.x = cvt_pk_bf16(e0[0], e0[1]); w.y = cvt_pk_bf16(e0[2], e0[3]); w.z = cvt_pk_bf16(e1[0], e1[1]); w.w = cvt_pk_bf16(e1[2], e1[3]);
                                    *(u32x4*)(base + tb2 + voff(s2, d)) = w; }
                            }
                        }
                        continue;
                    }
                    const int c = u.pn * BM + bj * HALF + wc * 32 + 8 * fq;
                    const f32x4 v0 = acc[ai][bj][m][0], v1 = acc[ai][bj][m][1];
                    if (c < 2816) {
                        size_t tb_; int mode_ = 0; const int d = c & 63;
                        if (c < 2048) { const int region = c >> 9, h = (c & 511) >> 6; tb_ = (size_t)region * 8388608u + (size_t)(b * 8 + h) * SEQ * 64; mode_ = region == 1 ? 1 : (region == 2 ? 2 : 0); }
                        else { const int idx = c - 2048, br = idx >> 8, kv = (idx >> 7) & 1, gg = (idx >> 6) & 1;
                            tb_ = (size_t)4 * 8388608u + (size_t)(((br * 2 + kv) * 2 + b) * 2 + gg) * SEQ * 64; mode_ = br == 0 ? 0 : (kv == 0 ? 1 : 2); if (br == 1) mode_ += 2; }
                        u32x4 w; w.x = cvt_pk_bf16(v0[0], v0[1]); w.y = cvt_pk_bf16(v0[2], v0[3]); w.z = cvt_pk_bf16(v1[0], v1[1]); w.w = cvt_pk_bf16(v1[2], v1[3]);
                        if (mode_ >= 3) {
                            unsigned char* bp = (unsigned char*)(base + tb_);
                            const unsigned f0 = cvt4_fp8(v0[0], v0[1], v0[2], v0[3]), f1 = cvt4_fp8(v1[0], v1[1], v1[2], v1[3]);
                            if (mode_ == 3) { u32x2 q; q.x = f0; q.y = f1; *(u32x2*)(bp + k8off(s, d)) = q; }
                            else { unsigned char* tp = bp + v8off(s, d);
                                tp[0] = (unsigned char)f0; tp[16] = (unsigned char)(f0 >> 8); tp[32] = (unsigned char)(f0 >> 16); tp[48] = (unsigned char)(f0 >> 24);
                                tp[64] = (unsigned char)f1; tp[80] = (unsigned char)(f1 >> 8); tp[96] = (unsigned char)(f1 >> 16); tp[112] = (unsigned char)(f1 >> 24); }
                        } else if (mode_ == 2) {
                            bf16* tp = base + tb_ + voff(s, d);
                            tp[0] = (bf16)(w.x & 0xffffu); tp[8] = (bf16)(w.x >> 16); tp[16] = (bf16)(w.y & 0xffffu); tp[24] = (bf16)(w.y >> 16);
                            tp[32] = (bf16)(w.z & 0xffffu); tp[40] = (bf16)(w.z >> 16); tp[48] = (bf16)(w.w & 0xffffu); tp[56] = (bf16)(w.w >> 16);
                        } else *(u32x4*)(base + tb_ + (mode_ == 1 ? koff(s, d) : (size_t)s * 64 + d)) = w;
                    } else if (c < IN_COLS) {
                        float* gp = gates + (size_t)row * 24 + (c - 2816);
                        f32x4 a, bb;
#define SIGM(x_) __builtin_amdgcn_rcpf(1.f + __builtin_amdgcn_exp2f((x_) * -1.4426950408889634f))
                        a.x = SIGM(v0.x); a.y = SIGM(v0.y); a.z = SIGM(v0.z); a.w = SIGM(v0.w);
                        bb.x = SIGM(v1.x); bb.y = SIGM(v1.y); bb.z = SIGM(v1.z); bb.w = SIGM(v1.w);
#undef SIGM
                        *(f32x4*)gp = a; *(f32x4*)(gp + 4) = bb;
                    }
                }
            }
    }
};
struct EpiOutBf16 {
    bf16* O; int ldc;
    __device__ __forceinline__ void operator()(const f32x4 (&acc)[2][2][4][2], const Unit& u, int wr, int wc, int fr, int fq) const {
#pragma unroll
        for (int ai = 0; ai < 2; ++ai)
#pragma unroll
            for (int m = 0; m < 4; ++m) {
                const int row = u.pm * BM + ai * HALF + wr * 64 + m * 16 + fr;
#pragma unroll
                for (int bj = 0; bj < 2; ++bj) {
                    bf16* p = O + (size_t)row * ldc + (u.pn % (ldc / BM)) * BM + bj * HALF + wc * 32 + 8 * fq;
                    const f32x4 v0 = acc[ai][bj][m][0], v1 = acc[ai][bj][m][1];
                    u32x4 w; w.x = cvt_pk_bf16(v0[0], v0[1]); w.y = cvt_pk_bf16(v0[2], v0[3]); w.z = cvt_pk_bf16(v1[0], v1[1]); w.w = cvt_pk_bf16(v1[2], v1[3]);
                    *(u32x4*)p = w;
                }
            }
    }
};
struct EpiMoeDown {
    bf16* O; bf16* P; int row0;
    __device__ __forceinline__ void operator()(const f32x4 (&acc)[2][2][4][2], const Unit& u, int wr, int wc, int fr, int fq) const {
        bf16* Ob = u.part < 0 ? O : P + ((ptrdiff_t)u.part * 2048 - row0) * 1024;
#pragma unroll
        for (int ai = 0; ai < 2; ++ai)
#pragma unroll
            for (int m = 0; m < 4; ++m) {
                const int row = u.pm * BM + ai * HALF + wr * 64 + m * 16 + fr;
#pragma unroll
                for (int bj = 0; bj < 2; ++bj) {
                    bf16* p = Ob + (ptrdiff_t)row * 1024 + (u.pn & 3) * BM + bj * HALF + wc * 32 + 8 * fq;
                    const f32x4 v0 = acc[ai][bj][m][0], v1 = acc[ai][bj][m][1];
                    u32x4 w; w.x = cvt_pk_bf16(v0[0], v0[1]); w.y = cvt_pk_bf16(v0[2], v0[3]); w.z = cvt_pk_bf16(v1[0], v1[1]); w.w = cvt_pk_bf16(v1[2], v1[3]);
                    *(u32x4*)p = w;
                }
            }
    }
};
struct EpiSwiglu {
    bf16* Hd; int ldh; int nNper;
    __device__ __forceinline__ void operator()(const f32x4 (&acc)[2][2][4][2], const Unit& u, int wr, int wc, int fr, int fq) const {
        const int pnl = u.pn % nNper;
#pragma unroll
        for (int ai = 0; ai < 2; ++ai)
#pragma unroll
            for (int m = 0; m < 4; ++m) {
                const int row = u.pm * BM + ai * HALF + wr * 64 + m * 16 + fr;
                float h[8];
#pragma unroll
                for (int n = 0; n < 2; ++n)
#pragma unroll
                    for (int j = 0; j < 4; ++j) { const float gt = acc[ai][0][m][n][j], up = acc[ai][1][m][n][j]; h[n * 4 + j] = gt * __builtin_amdgcn_rcpf(1.f + __builtin_amdgcn_exp2f(gt * -1.4426950408889634f)) * up; }
                u32x4 w; w.x = cvt_pk_bf16(h[0], h[1]); w.y = cvt_pk_bf16(h[2], h[3]); w.z = cvt_pk_bf16(h[4], h[5]); w.w = cvt_pk_bf16(h[6], h[7]);
                *(u32x4*)(Hd + (size_t)row * ldh + pnl * HALF + wc * 32 + 8 * fq) = w;
            }
    }
};

struct CmpOrder { static constexpr bool SPLIT = false; int G, c;
    __device__ bool next(int i, Unit& u) const { const int L = i * G + c; if (L >= 16) return false; u.pm = L; u.pn = L >> 3; u.ga = 0; u.gl = 0; return true; } };
__device__ __forceinline__ float gelu_tanh_pg(float x) { const float uu = 0.7978845608028654f * (x + 0.044715f * x * x * x); const float t = 1.f - 2.f / (__expf(2.f * uu) + 1.f); return 0.5f * x * (1.f + t); }
struct EpiCmpHid {
    bf16* Hd; const float* bias;
    __device__ __forceinline__ void operator()(const f32x4 (&acc)[2][2][4][2], const Unit& u, int wr, int wc, int fr, int fq) const {
        const float* bp = bias + u.pn * 256;
#pragma unroll
        for (int ai = 0; ai < 2; ++ai)
#pragma unroll
            for (int m = 0; m < 4; ++m) {
                const int row = u.pm * BM + ai * HALF + wr * 64 + m * 16 + fr;
#pragma unroll
                for (int bj = 0; bj < 2; ++bj) {
                    const int col = bj * HALF + wc * 32 + 8 * fq;
                    const f32x4 b0 = *(const f32x4*)(bp + col), b1 = *(const f32x4*)(bp + col + 4);
                    float h[8];
#pragma unroll
                    for (int j = 0; j < 4; ++j) { h[j] = gelu_tanh_pg(acc[ai][bj][m][0][j] + b0[j]); h[4 + j] = gelu_tanh_pg(acc[ai][bj][m][1][j] + b1[j]); }
                    u32x4 w; w.x = cvt_pk_bf16(h[0], h[1]); w.y = cvt_pk_bf16(h[2], h[3]); w.z = cvt_pk_bf16(h[4], h[5]); w.w = cvt_pk_bf16(h[6], h[7]);
                    *(u32x4*)(Hd + (size_t)row * 256 + col) = w;
                }
            }
    }
};
}

#define XB_TMO      128
#define XB_XCNT(j)  (256  + 64 * (j))
#define XB_XSUB(j)  (1280 + 64 * (j))
#define XB_XGEN(j)  (2304 + 64 * (j))
#define XB_TOP      3328
#define XB_TOPGEN   3392
#define XCD_BAR_WORDS 3456
#define XB_SPIN_CAP (1u << 18)
__device__ __forceinline__ unsigned xb_ld(unsigned* p)              { return __hip_atomic_load(p, __ATOMIC_RELAXED, __HIP_MEMORY_SCOPE_AGENT); }
__device__ __forceinline__ unsigned xb_add(unsigned* p, unsigned v) { return __hip_atomic_fetch_add(p, v, __ATOMIC_RELAXED, __HIP_MEMORY_SCOPE_AGENT); }
__device__ __forceinline__ unsigned xb_xcc_id() { return (unsigned)__builtin_amdgcn_s_getreg((3 << 11) | 20) & 0xFu; }
#define XB_SPIN(cond, bar) do { unsigned _sp = 0; while (cond) { __builtin_amdgcn_s_sleep(1); \
    if ((++_sp & 255u) == 0u) { if (xb_ld(&(bar)[XB_TMO])) break; if (_sp > XB_SPIN_CAP) { atomicAdd(&(bar)[XB_TMO], 1u); break; } } } } while (0)
struct XcdBarrier { unsigned* bar; unsigned x; volatile LAS unsigned* st; };
__device__ __forceinline__ XcdBarrier xcd_barrier_post(unsigned* bar, volatile LAS unsigned* st) {
    XcdBarrier b; b.bar = bar; b.x = xb_xcc_id(); b.st = st;
    if (threadIdx.x == 0) (void)xb_add(&bar[XB_XCNT(b.x)], 1u);
    return b;
}
__device__ __forceinline__ void xcd_barrier_complete(unsigned* bar, unsigned x, unsigned& nloc, unsigned& nx) {
    const unsigned G = gridDim.x * gridDim.y * gridDim.z;
    unsigned sum, cnt, mine, sp = 0u;
    for (;;) {
        sum = 0u; cnt = 0u; mine = 0u;
#pragma unroll
        for (unsigned j = 0; j < 16; ++j) { const unsigned c = xb_ld(&bar[XB_XCNT(j)]); sum += c; cnt += (c > 0u) ? 1u : 0u; mine = (j == x) ? c : mine; }
        if (sum == G) break;
        __builtin_amdgcn_s_sleep(1);
        if ((++sp & 255u) == 0u) { if (xb_ld(&bar[XB_TMO])) break; if (sp > XB_SPIN_CAP) { atomicAdd(&bar[XB_TMO], 1u); break; } }
    }
    nloc = mine > 0u ? mine : 1u; nx = cnt > 0u ? cnt : 1u;
}
__device__ __forceinline__ void xcd_barrier(const XcdBarrier& b) {
    asm volatile("s_waitcnt vmcnt(0)" ::: "memory");
    __syncthreads();
    if (threadIdx.x == 0) {
        unsigned* bar = b.bar;
        __builtin_amdgcn_s_waitcnt(0);
        unsigned nloc = b.st[0], nx = b.st[1];
        if (nloc == 0u) { xcd_barrier_complete(bar, b.x, nloc, nx); b.st[0] = nloc; b.st[1] = nx; }
        const unsigned old = xb_add(&bar[XB_XSUB(b.x)], 1u);
        const unsigned gen = old / nloc;
        if (old + 1u == (gen + 1u) * nloc) {
            __builtin_amdgcn_fence(__ATOMIC_RELEASE, "agent");
            asm volatile("s_waitcnt vmcnt(0)" ::: "memory");
            const unsigned og = xb_add(&bar[XB_TOP], 1u);
            const unsigned tg = og / nx;
            if (og + 1u == (tg + 1u) * nx) xb_add(&bar[XB_TOPGEN], 1u);
            else XB_SPIN(xb_ld(&bar[XB_TOPGEN]) == tg, bar);
            __builtin_amdgcn_fence(__ATOMIC_ACQUIRE, "agent");
            xb_add(&bar[XB_XGEN(b.x)], 1u);
            asm volatile("s_waitcnt vmcnt(0)" ::: "memory");
        } else {
            XB_SPIN(xb_ld(&bar[XB_XGEN(b.x)]) == gen, bar);
            __builtin_amdgcn_fence(__ATOMIC_ACQUIRE, "agent");
            asm volatile("s_waitcnt vmcnt(0)" ::: "memory");
        }
    }
    __syncthreads();
}

struct Frame {
    LAS unsigned char* lds;
    int tid, lane, wave, vcu, G;
    const Args* a;
    unsigned char* ws;
};
#define LDS_WAIT() asm volatile("s_waitcnt lgkmcnt(0)" ::: "memory")

struct TItem { const float* W; bf16* WT; int K, N, mode, r; };
__device__ __forceinline__ void transpose_load(const TItem& t, int lane, float (&tv)[32]) {
    const int nblk = (t.N + 31) / 32, kb = t.r / nblk, nb = t.r % nblk, k0 = 64 * kb, n0 = 32 * nb;
    int nn = n0 + (lane & 31); nn = nn < t.N ? nn : t.N - 1;
    const float* wp = t.W + (size_t)(k0 + (lane >> 5)) * t.N + nn;
#pragma unroll
    for (int i = 0; i < 32; ++i) tv[i] = wp[(size_t)(2 * i) * t.N];
}
__device__ __forceinline__ void transpose_store(const TItem& t, int lane, LAS float* scr, const float (&tv)[32]) {
    const int nblk = (t.N + 31) / 32, kb = t.r / nblk, nb = t.r % nblk, k0 = 64 * kb, n0 = 32 * nb;
    const bool okn = n0 + (lane & 31) < t.N;
#pragma unroll
    for (int i = 0; i < 32; ++i) { const int kk = 2 * i + (lane >> 5); scr[kk * 33 + (lane & 31)] = okn ? tv[i] : 0.f; }
    LDS_WAIT(); asm volatile("" ::: "memory");
    const int c = lane & 7;
    const int drow0 = (t.mode == 0 ? n0 : ((n0 >> 7) * 256 + (n0 & 127) + (t.mode == 2 ? 128 : 0)));
#pragma unroll
    for (int j = 0; j < 4; ++j) { const int n = (lane >> 3) + 8 * j; const LAS float* s = scr + (8 * c) * 33 + n;
        u32x4 o; o.x = cvt_pk_bf16(s[0 * 33], s[1 * 33]); o.y = cvt_pk_bf16(s[2 * 33], s[3 * 33]); o.z = cvt_pk_bf16(s[4 * 33], s[5 * 33]); o.w = cvt_pk_bf16(s[6 * 33], s[7 * 33]);
        *(u32x4*)(t.WT + (size_t)(drow0 + n) * t.K + k0 + 8 * c) = o; }
    LDS_WAIT(); asm volatile("" ::: "memory");
}
template <bool SILU, int NVEC>
__device__ __forceinline__ void block_gemv(Frame& F, const float* a0, const float* a1, int K, const float* W, int N, int col0, const float* bias, float* out0, float* out1) {
    const int col = col0 + F.lane, kper = K / NWAVES, kbeg = F.wave * kper;
    float s0 = 0.f, s1 = 0.f;
#pragma unroll 32
    for (int k = kbeg; k < kbeg + kper; ++k) {
        const float w = W[(size_t)k * N + col];
        float x0 = a0[k]; if (SILU) x0 = x0 / (1.f + __expf(-x0));
        s0 += x0 * w;
        if (NVEC == 2) { float x1 = a1[k]; if (SILU) x1 = x1 / (1.f + __expf(-x1)); s1 += x1 * w; }
    }
    LAS float* red = (LAS float*)(F.lds + RING_OFF);
    red[(F.wave * 2 + 0) * 64 + F.lane] = s0; red[(F.wave * 2 + 1) * 64 + F.lane] = s1;
    __syncthreads();
    if (F.wave == 0) {
        float t0 = 0.f, t1 = 0.f;
#pragma unroll
        for (int w = 0; w < NWAVES; ++w) { t0 += red[(w * 2 + 0) * 64 + F.lane]; t1 += red[(w * 2 + 1) * 64 + F.lane]; }
        const float bv = bias ? bias[col] : 0.f;
        out0[col] = t0 + bv; if (NVEC == 2) out1[col] = t1 + bv;
    }
    __syncthreads();
}
__device__ __forceinline__ void phase_prologue(Frame& F) {
    const Args& A = *F.a; unsigned char* ws = F.ws;
    for (int it = F.vcu; it < 208; it += F.G) {
        if (it < 192) { const int l = it / 96, cc = it % 96;
            float* mod = (float*)(ws + WS_MOD) + (size_t)l * 2 * 6144;
            block_gemv<true, 2>(F, A.in[1], A.in[1] + DM, DM, A.in[3] + (size_t)l * DM * 6144, 6144, cc * 64, A.in[4] + (size_t)l * 6144, mod, mod + 6144);
        } else { const int r = it - 192, lk = r / 4, cc = r % 4, l = lk >> 1, kv = lk & 1;
            const float* pos = A.in[kv ? 16 : 13] + (size_t)l * 2048; const float* w1 = A.in[kv ? 17 : 14] + (size_t)l * 2048 * 256;
            float* cb = (float*)(ws + WS_CBIAS) + (size_t)(l * 2 + kv) * 256;
            block_gemv<false, 1>(F, pos, pos, 2048, w1, 256, cc * 64, nullptr, cb, cb);
        }
    }
    LAS float* scr = (LAS float*)(F.lds + RING_OFF + F.wave * 16384);
    const int gw = F.vcu * NWAVES + F.wave, NGW = F.G * NWAVES;
    constexpr int PER_L = 1424 + 512 + 256 + 256 + 8 + 8, N_L = 2 * PER_L, N_F = 3 * 1408, PER_E = 3 * 1792, N_ALL = N_L + N_F + NE * PER_E;
    auto decode = [&](int it, TItem& t) {
        int r = it; const float* W; int K, N, mode = 0; bf16* WT;
        if (r < N_L) { const int l = r / PER_L; r %= PER_L;
            if (r < 1424) { W = A.in[9] + (size_t)l * DM * IN_COLS; K = DM; N = IN_COLS; WT = (bf16*)(ws + WS_WIN) + (size_t)l * NPROJ * DM; }
            else if (r < 1936) { r -= 1424; W = A.in[10] + (size_t)l * DM * DM; K = DM; N = DM; WT = (bf16*)(ws + WS_WOUT) + (size_t)l * DM * DM; }
            else if (r < 2192) { r -= 1936; W = A.in[14] + (size_t)l * 2048 * 256; K = 2048; N = 256; WT = (bf16*)(ws + WS_CW1) + (size_t)(l * 2 + 0) * 256 * 2048; }
            else if (r < 2448) { r -= 2192; W = A.in[17] + (size_t)l * 2048 * 256; K = 2048; N = 256; WT = (bf16*)(ws + WS_CW1) + (size_t)(l * 2 + 1) * 256 * 2048; }
            else if (r < 2456) { r -= 2448; W = A.in[15] + (size_t)l * 256 * 64; K = 256; N = 64; WT = (bf16*)(ws + WS_CW2) + (size_t)(l * 2 + 0) * 64 * 256; }
            else { r -= 2456; W = A.in[18] + (size_t)l * 256 * 64; K = 256; N = 64; WT = (bf16*)(ws + WS_CW2) + (size_t)(l * 2 + 1) * 64 * 256; }
        } else if (r < N_L + N_F) { r -= N_L; const int which = r / 1408; r %= 1408;
            if (which == 0) { W = A.in[19]; K = DM; N = DFF; WT = (bf16*)(ws + WS_FGU); mode = 1; }
            else if (which == 1) { W = A.in[20]; K = DM; N = DFF; WT = (bf16*)(ws + WS_FGU); mode = 2; }
            else { W = A.in[21]; K = DFF; N = DM; WT = (bf16*)(ws + WS_FD); }
        } else { r -= N_L + N_F; const int e = r / PER_E; r %= PER_E; const int which = r / 1792; r %= 1792;
            if (which == 0) { W = A.in[24] + (size_t)e * DM * DFE; K = DM; N = DFE; WT = (bf16*)(ws + WS_MGU) + (size_t)e * 7168 * DM; mode = 1; }
            else if (which == 1) { W = A.in[25] + (size_t)e * DM * DFE; K = DM; N = DFE; WT = (bf16*)(ws + WS_MGU) + (size_t)e * 7168 * DM; mode = 2; }
            else { W = A.in[26] + (size_t)e * DFE * DM; K = DFE; N = DM; WT = (bf16*)(ws + WS_MD) + (size_t)e * DM * DFE; }
        }
        t.W = W; t.WT = WT; t.K = K; t.N = N; t.mode = mode; t.r = r;
    };
    int it = gw; TItem ia, ib; float ta[32], tb[32];
    if (it < N_ALL) {
        decode(it, ia); transpose_load(ia, F.lane, ta);
        for (;;) {
            const int n1 = it + NGW; const bool h1 = n1 < N_ALL;
            decode(h1 ? n1 : it, ib); transpose_load(ib, F.lane, tb);
            transpose_store(ia, F.lane, scr, ta);
            if (!h1) break;
            const int n2 = n1 + NGW; const bool h2 = n2 < N_ALL;
            decode(h2 ? n2 : n1, ia); transpose_load(ia, F.lane, ta);
            transpose_store(ib, F.lane, scr, tb);
            if (!h2) break;
            it = n2;
        }
    }
}

__device__ __forceinline__ void ld_row(const float* p, int lane, f32x4 (&v)[4]) {
#pragma unroll
    for (int i = 0; i < 4; ++i) v[i] = ((const f32x4*)p)[lane + 64 * i];
}
__device__ __forceinline__ void ld_row_bf16(const bf16* p, int lane, f32x4 (&v)[4]) {
#pragma unroll
    for (int i = 0; i < 4; ++i) { const u32x2 w = ((const u32x2*)p)[lane + 64 * i]; v[i] = (f32x4){__uint_as_float(w.x << 16), __uint_as_float(w.x & 0xffff0000u), __uint_as_float(w.y << 16), __uint_as_float(w.y & 0xffff0000u)}; }
}
__device__ __forceinline__ float sumsq(const f32x4 (&v)[4]) {
    float s = 0.f;
#pragma unroll
    for (int i = 0; i < 4; ++i) s += (v[i].x * v[i].x + v[i].y * v[i].y) + (v[i].z * v[i].z + v[i].w * v[i].w);
    return s;
}
__device__ __forceinline__ void st_row_bf16(bf16* p, int lane, const f32x4 (&v)[4]) {
#pragma unroll
    for (int i = 0; i < 4; ++i) { u32x2 w; w.x = cvt_pk_bf16(v[i].x, v[i].y); w.y = cvt_pk_bf16(v[i].z, v[i].w); ((u32x2*)p)[lane + 64 * i] = w; }
}
__device__ __forceinline__ void modulate(const f32x4 (&x)[4], float r, const float* g, const float* scale, const float* shift, int lane, f32x4 (&h)[4]) {
    f32x4 gv[4], sc[4], sh[4]; ld_row(g, lane, gv); ld_row(scale, lane, sc); ld_row(shift, lane, sh);
#pragma unroll
    for (int i = 0; i < 4; ++i) h[i] = x[i] * r * gv[i] * (1.f + sc[i]) + sh[i];
}
__device__ __forceinline__ void phase_h0(Frame& F) {
    const Args& A = *F.a; const float* mod = (const float*)(F.ws + WS_MOD);
    bf16* H = (bf16*)(F.ws + WS_H);
    for (int row = F.vcu * NWAVES + F.wave; row < T; row += F.G * NWAVES) {
        const int b = row >> 13; const float* mb = mod + (size_t)(0 * 2 + b) * 6144;
        f32x4 x[4], h[4]; ld_row(A.in[0] + (size_t)row * DM, F.lane, x);
        const float r = 1.f / sqrtf(wave_sum(sumsq(x)) * (1.f / DM) + EPS);
        modulate(x, r, A.in[5], mb + 1024, mb, F.lane, h);
        st_row_bf16(H + (size_t)row * DM, F.lane, h);
    }
}
__device__ __forceinline__ void phase_merge(Frame& F, int layer) {
    const Args& A = *F.a; const float* oraw = (const float*)(F.ws + AR_ORAW); bf16* H = (bf16*)(F.ws + WS_H);
    const float* gsb = A.in[11] + layer * 512; const float* gns = A.in[12] + layer * 512;
    for (int row = F.vcu * NWAVES + F.wave; row < T; row += F.G * NWAVES) {
        f32x4 v[4]; ld_row(oraw + (size_t)row * DM, F.lane, v);
        float s0 = (v[0].x * v[0].x + v[0].y * v[0].y) + (v[0].z * v[0].z + v[0].w * v[0].w) + (v[1].x * v[1].x + v[1].y * v[1].y) + (v[1].z * v[1].z + v[1].w * v[1].w);
        float s1 = (v[2].x * v[2].x + v[2].y * v[2].y) + (v[2].z * v[2].z + v[2].w * v[2].w) + (v[3].x * v[3].x + v[3].y * v[3].y) + (v[3].z * v[3].z + v[3].w * v[3].w);
        const float r0 = 1.f / sqrtf(wave_sum(s0) * (1.f / 512) + EPS), r1 = 1.f / sqrtf(wave_sum(s1) * (1.f / 512) + EPS);
        f32x4 o[4];
#pragma unroll
        for (int i = 0; i < 2; ++i) { o[i] = v[i] * r0 * ((const f32x4*)gsb)[F.lane + 64 * i]; o[2 + i] = v[2 + i] * r1 * ((const f32x4*)gns)[F.lane + 64 * i]; }
        st_row_bf16(H + (size_t)row * DM, F.lane, o);
    }
}
__device__ __forceinline__ void phase_post_mix(Frame& F, int layer) {
    const Args& A = *F.a; const float* mod = (const float*)(F.ws + WS_MOD);
    const bf16* mbuf = (const bf16*)(F.ws + AR_M); bf16* H = (bf16*)(F.ws + WS_H);
    const float* xin = layer == 0 ? A.in[0] : A.out;
    unsigned* cnt = (unsigned*)(F.ws + WS_CTL) + CW_CNT; unsigned* tokinfo = (unsigned*)(F.ws + AR_TOKINFO);
    for (int row = F.vcu * NWAVES + F.wave; row < T; row += F.G * NWAVES) {
        const int b = row >> 13; const float* mb = mod + (size_t)(layer * 2 + b) * 6144;
        f32x4 x[4], m[4], g[4], gt[4], h[4];
        ld_row(xin + (size_t)row * DM, F.lane, x); ld_row_bf16(mbuf + (size_t)row * DM, F.lane, m);
        ld_row(A.in[6] + layer * DM, F.lane, g); ld_row(mb + 2048, F.lane, gt);
        const float r = 1.f / sqrtf(wave_sum(sumsq(m)) * (1.f / DM) + EPS);
#pragma unroll
        for (int i = 0; i < 4; ++i) { x[i] = x[i] + gt[i] * (m[i] * r * g[i]); ((f32x4*)(A.out + (size_t)row * DM))[F.lane + 64 * i] = x[i]; }
        const float r2 = 1.f / sqrtf(wave_sum(sumsq(x)) * (1.f / DM) + EPS);
        modulate(x, r2, A.in[7] + layer * DM, mb + 4096, mb + 3072, F.lane, h);
        st_row_bf16(H + (size_t)row * DM, F.lane, h);
        if (layer == 1) {
            const float* wr = A.in[22]; float lg[8];
#pragma unroll
            for (int e = 0; e < 8; ++e) lg[e] = 0.f;
#pragma unroll
            for (int i = 0; i < 4; ++i)
#pragma unroll
                for (int j = 0; j < 4; ++j) { const int k = i * 256 + F.lane * 4 + j; const f32x4 w0 = *(const f32x4*)(wr + k * 8), w1 = *(const f32x4*)(wr + k * 8 + 4); const float hv = h[i][j];
                    lg[0] += hv * w0.x; lg[1] += hv * w0.y; lg[2] += hv * w0.z; lg[3] += hv * w0.w; lg[4] += hv * w1.x; lg[5] += hv * w1.y; lg[6] += hv * w1.z; lg[7] += hv * w1.w; }
            float mx = -3.0e38f;
#pragma unroll
            for (int e = 0; e < 8; ++e) { lg[e] = wave_sum(lg[e]) + A.in[23][e]; mx = fmaxf(mx, lg[e]); }
            float p[8], sum = 0.f;
#pragma unroll
            for (int e = 0; e < 8; ++e) { p[e] = __expf(lg[e] - mx); sum += p[e]; }
            const float inv = 1.f / sum;
#pragma unroll
            for (int e = 0; e < 8; ++e) p[e] *= inv;
            int e0 = 0; float p0 = p[0];
#pragma unroll
            for (int e = 1; e < 8; ++e) if (p[e] > p0) { p0 = p[e]; e0 = e; }
            int e1 = -1; float p1 = -1.f;
#pragma unroll
            for (int e = 0; e < 8; ++e) if (e != e0 && p[e] > p1) { p1 = p[e]; e1 = e; }
            const float ws2 = p0 + p1;
            if (F.lane == 0) {
                const unsigned pos0 = atomicAdd(&cnt[e0], 1u), pos1 = atomicAdd(&cnt[e1], 1u);
                u32x4 a0, a1; a0.x = (unsigned)e0; a0.y = (unsigned)e1; a0.z = pos0; a0.w = pos1;
                a1.x = __float_as_uint(p0 / ws2); a1.y = __float_as_uint(p1 / ws2); a1.z = 0u; a1.w = 0u;
                *(u32x4*)(tokinfo + (size_t)row * 8) = a0; *(u32x4*)(tokinfo + (size_t)row * 8 + 4) = a1;
                int* rowtok = (int*)(F.ws + AR_ROWTOK);
                rowtok[e0 * 16384 + (int)pos0] = row; rowtok[e1 * 16384 + (int)pos1] = row;
            }
        }
    }
}
constexpr int MOETBL_OFF = LDSCTL_OFF + 1280;
__device__ __forceinline__ void moe_table_build(Frame& F) {
    LAS int* tbl = (LAS int*)(F.lds + MOETBL_OFF);
    if (F.tid == 0) {
        unsigned* cnt = (unsigned*)(F.ws + WS_CTL) + CW_CNT; int acc = 0;
        for (int e = 0; e < 8; ++e) { const int c = (int)__hip_atomic_load(&cnt[e], __ATOMIC_RELAXED, __HIP_MEMORY_SCOPE_AGENT); tbl[e] = acc; tbl[8 + e] = c; tbl[16 + e] = (c + 255) >> 8; acc += (c + 255) >> 8; }
        int nfull = acc, S = 1;
        if ((F.G & 3) == 0) { const int nf = (acc * 4 / F.G) * (F.G / 4), ntail = acc - nf; if (ntail > 0 && ntail <= 8 && ntail * 28 <= F.G) { nfull = nf; S = 7; } }
        tbl[24] = nfull; tbl[25] = S;
    }
    __syncthreads();
}
__device__ __forceinline__ void moe_y_row(Frame& F, int r, int tail0, int nS, f32x4 (&y)[4]) {
    if (r < tail0 || nS <= 1) { ld_row_bf16((const bf16*)(F.ws + WS_Y) + (size_t)r * DM, F.lane, y); return; }
    const bf16* pp = (const bf16*)(F.ws + WS_YPART) + (size_t)(r - tail0) * DM;
    ld_row_bf16(pp, F.lane, y);
    for (int s = 1; s < nS; ++s) { f32x4 t[4]; ld_row_bf16(pp + (size_t)s * 2048 * DM, F.lane, t);
#pragma unroll
        for (int i = 0; i < 4; ++i) y[i] = y[i] + t[i]; }
}
__device__ __forceinline__ void phase_post_ffn(Frame& F, int layer) {
    const Args& A = *F.a; const float* mod = (const float*)(F.ws + WS_MOD); bf16* H = (bf16*)(F.ws + WS_H);
    if (layer == 1) moe_table_build(F);
    const LAS int* tbl = (const LAS int*)(F.lds + MOETBL_OFF);
    const unsigned* tokinfo = (const unsigned*)(F.ws + AR_TOKINFO);
    for (int row = F.vcu * NWAVES + F.wave; row < T; row += F.G * NWAVES) {
        const int b = row >> 13; const float* mb = mod + (size_t)(layer * 2 + b) * 6144;
        f32x4 x[4], f[4], g[4], gt[4];
        ld_row(A.out + (size_t)row * DM, F.lane, x);
        if (layer == 0) ld_row_bf16((const bf16*)(F.ws + AR_FOUT) + (size_t)row * DM, F.lane, f);
        else {
            const u32x4 a0 = *(const u32x4*)(tokinfo + (size_t)row * 8), a1 = *(const u32x4*)(tokinfo + (size_t)row * 8 + 4);
            const int r0 = tbl[a0.x] * 256 + (int)a0.z, r1 = tbl[a0.y] * 256 + (int)a0.w;
            const float w0 = __uint_as_float(a1.x), w1 = __uint_as_float(a1.y);
            f32x4 y0[4], y1[4]; const int tail0 = tbl[24] * 256, nS = tbl[25];
            moe_y_row(F, r0, tail0, nS, y0); moe_y_row(F, r1, tail0, nS, y1);
#pragma unroll
            for (int i = 0; i < 4; ++i) f[i] = y0[i] * w0 + y1[i] * w1;
        }
        ld_row(A.in[8] + layer * DM, F.lane, g); ld_row(mb + 5120, F.lane, gt);
        const float r = 1.f / sqrtf(wave_sum(sumsq(f)) * (1.f / DM) + EPS);
#pragma unroll
        for (int i = 0; i < 4; ++i) { x[i] = x[i] + gt[i] * (f[i] * r * g[i]); ((f32x4*)(A.out + (size_t)row * DM))[F.lane + 64 * i] = x[i]; }
        if (layer == 0) {
            const float* mb1 = mod + (size_t)(1 * 2 + b) * 6144; f32x4 h[4];
            const float r2 = 1.f / sqrtf(wave_sum(sumsq(x)) * (1.f / DM) + EPS);
            modulate(x, r2, A.in[5] + DM, mb1 + 1024, mb1, F.lane, h);
            st_row_bf16(H + (size_t)row * DM, F.lane, h);
        }
    }
}

__device__ __forceinline__ float gelu_tanh(float x) { const float u = 0.7978845608028654f * (x + 0.044715f * x * x * x); const float t = 1.f - 2.f / (__expf(2.f * u) + 1.f); return 0.5f * x * (1.f + t); }
__device__ __forceinline__ void cmp_out_unit(Frame& F, int layer, int pm) {
    const int t = pm >> 1, kv = t >> 2, bg = t & 3, rbase = (pm & 1) * 256;
    const bf16* hid = (const bf16*)(F.ws + AR_CHID) + (size_t)pm * 256 * 256;
    const bf16* w2t = (const bf16*)(F.ws + WS_CW2) + (size_t)(layer * 2 + kv) * 64 * 256;
    bf16* outp = (bf16*)(F.ws + AR_KC) + (size_t)(kv * 4 + bg) * 512 * 64;
    const int w = F.wave, fr = F.lane & 15, fq = F.lane >> 4;
    f32x4 acc[2][4];
#pragma unroll
    for (int m = 0; m < 2; ++m)
#pragma unroll
        for (int n = 0; n < 4; ++n) acc[m][n] = (f32x4){0.f, 0.f, 0.f, 0.f};
#pragma unroll
    for (int kk = 0; kk < 8; ++kk) {
        bf16x8 a[2], b[4];
#pragma unroll
        for (int m = 0; m < 2; ++m) a[m] = *(const bf16x8*)(hid + (size_t)(w * 32 + m * 16 + fr) * 256 + kk * 32 + fq * 8);
#pragma unroll
        for (int n = 0; n < 4; ++n) b[n] = *(const bf16x8*)(w2t + (size_t)(n * 16 + fr) * 256 + kk * 32 + fq * 8);
#pragma unroll
        for (int m = 0; m < 2; ++m)
#pragma unroll
            for (int n = 0; n < 4; ++n) acc[m][n] = __builtin_amdgcn_mfma_f32_16x16x32_bf16(a[m], b[n], acc[m][n], 0, 0, 0);
    }
#pragma unroll
    for (int m = 0; m < 2; ++m)
#pragma unroll
        for (int n = 0; n < 4; ++n)
#pragma unroll
            for (int r = 0; r < 4; ++r) { const int row = rbase + w * 32 + m * 16 + fq * 4 + r, col = n * 16 + fr;
                const bf16 ov = row < NCMP ? (bf16)(cvt_pk_bf16(acc[m][n][r], 0.f) & 0xffffu) : (bf16)0;
                outp[kv == 0 ? koff(row, col) : voff(row, col)] = ov; }
}

struct KF { bf16x8 lo, hi; };
__device__ __forceinline__ int lane_off(int lane) { return (lane >> 4) * 128 + (lane & 15) * 8; }
__device__ __forceinline__ KF ld_kf(const bf16* row, int fq) { KF k; k.lo = *(const bf16x8*)(row + 8 * fq); k.hi = *(const bf16x8*)(row + 32 + 8 * fq); return k; }
__device__ __forceinline__ KF ld_kt(const bf16* Kt, int k0, int lane) { KF k; const bf16* p = Kt + (size_t)(k0 >> 4) * 1024 + lane_off(lane); k.lo = *(const bf16x8*)p; k.hi = *(const bf16x8*)(p + 512); return k; }
__device__ __forceinline__ bf16x8 ld_vt(const bf16* Vt, int k0, int dt, int lane) { return *(const bf16x8*)(Vt + (size_t)(k0 >> 5) * 2048 + dt * 512 + lane_off(lane)); }
__device__ __forceinline__ f32x4 qk16(const KF& k, const KF& q) { f32x4 z = {0.f, 0.f, 0.f, 0.f}; z = __builtin_amdgcn_mfma_f32_16x16x32_bf16(k.lo, q.lo, z, 0, 0, 0); z = __builtin_amdgcn_mfma_f32_16x16x32_bf16(k.hi, q.hi, z, 0, 0, 0); return z; }
__device__ __forceinline__ bf16x8 pack_p(const f32x4& p0, const f32x4& p1) { const u32x4 w = {cvt_pk_bf16(p0[0], p0[1]), cvt_pk_bf16(p0[2], p0[3]), cvt_pk_bf16(p1[0], p1[1]), cvt_pk_bf16(p1[2], p1[3])}; return __builtin_bit_cast(bf16x8, w); }
__device__ __forceinline__ float fq_max(float v) {
    auto a = __builtin_amdgcn_permlane16_swap(__float_as_uint(v), __float_as_uint(v), false, false); v = fmaxf(__uint_as_float(a[0]), __uint_as_float(a[1]));
    auto b = __builtin_amdgcn_permlane32_swap(__float_as_uint(v), __float_as_uint(v), false, false); return fmaxf(__uint_as_float(b[0]), __uint_as_float(b[1])); }
__device__ __forceinline__ float fq_sum(float v) {
    auto a = __builtin_amdgcn_permlane16_swap(__float_as_uint(v), __float_as_uint(v), false, false); v = __uint_as_float(a[0]) + __uint_as_float(a[1]);
    auto b = __builtin_amdgcn_permlane32_swap(__float_as_uint(v), __float_as_uint(v), false, false); return __uint_as_float(b[0]) + __uint_as_float(b[1]); }
__device__ __forceinline__ float xor16f(float v) { auto a = __builtin_amdgcn_permlane16_swap(__float_as_uint(v), __float_as_uint(v), false, false); return __uint_as_float(((threadIdx.x >> 4) & 1) ? a[0] : a[1]); }
__device__ __forceinline__ float xor32f(float v) { auto a = __builtin_amdgcn_permlane32_swap(__float_as_uint(v), __float_as_uint(v), false, false); return __uint_as_float(((threadIdx.x >> 5) & 1) ? a[0] : a[1]); }
__device__ __forceinline__ float quad_x1(float v) { return __uint_as_float(__builtin_amdgcn_update_dpp(0, __float_as_uint(v), 0xB1, 0xf, 0xf, true)); }
__device__ __forceinline__ float quad_x2(float v) { return __uint_as_float(__builtin_amdgcn_update_dpp(0, __float_as_uint(v), 0x4E, 0xf, 0xf, true)); }
constexpr float QK_C = 0.125f * 1.4426950408889634f;
constexpr float NEG_INF = -__builtin_huge_valf();
__device__ __forceinline__ bf16x8 osm_step(f32x4& s0, f32x4& s1, float& m, float& l, f32x4 (&O)[4]) {
    float smax = fmaxf(fmaxf(fmaxf(s0[0], s0[1]), fmaxf(s0[2], s0[3])), fmaxf(fmaxf(s1[0], s1[1]), fmaxf(s1[2], s1[3])));
    smax = fq_max(smax);
    {
        const float mnew = fmaxf(m, smax), muse = (mnew == NEG_INF) ? 0.f : mnew;
        const float alpha = __builtin_amdgcn_exp2f(m - muse);
        l *= alpha; m = mnew;
#pragma unroll
        for (int dt = 0; dt < 4; ++dt) O[dt] = O[dt] * alpha;
    }
    const float muse = (m == NEG_INF) ? 0.f : m;
    float ps = 0.f;
#pragma unroll
    for (int r = 0; r < 4; ++r) { s0[r] = __builtin_amdgcn_exp2f(s0[r] - muse); s1[r] = __builtin_amdgcn_exp2f(s1[r] - muse); ps += s0[r] + s1[r]; }
    l += ps;
    return pack_p(s0, s1);
}

__device__ __forceinline__ void osm_step8x2(f32x4& a0, f32x4& a1, float& mA, float& lA, f32x4 (&OA)[4], f32x4& b0, f32x4& b1, float& mB, float& lB, f32x4 (&OB)[4], long& pa, long& pb) {
    float xa = fmaxf(fmaxf(fmaxf(a0[0], a0[1]), fmaxf(a0[2], a0[3])), fmaxf(fmaxf(a1[0], a1[1]), fmaxf(a1[2], a1[3])));
    float xb = fmaxf(fmaxf(fmaxf(b0[0], b0[1]), fmaxf(b0[2], b0[3])), fmaxf(fmaxf(b1[0], b1[1]), fmaxf(b1[2], b1[3])));
    xa = fq_max(xa); xb = fq_max(xb);
    const float nA = fmaxf(mA, xa), nB = fmaxf(mB, xb);
    if (__builtin_amdgcn_ballot_w64((nA > mA) || (nB > mB)) != 0ull) {
        const float ua = (nA == NEG_INF) ? 0.f : nA, ub = (nB == NEG_INF) ? 0.f : nB;
        const float fa = __builtin_amdgcn_exp2f(mA - ua), fb = __builtin_amdgcn_exp2f(mB - ub);
        lA *= fa; lB *= fb; mA = nA; mB = nB;
#pragma unroll
        for (int dt = 0; dt < 4; ++dt) { OA[dt] = OA[dt] * fa; OB[dt] = OB[dt] * fb; }
    }
    const float ua = ((mA == NEG_INF) ? 0.f : mA) - 6.f, ub = ((mB == NEG_INF) ? 0.f : mB) - 6.f;
    float sa = 0.f, sb = 0.f;
#pragma unroll
    for (int r = 0; r < 4; ++r) { a0[r] = __builtin_amdgcn_exp2f(a0[r] - ua); a1[r] = __builtin_amdgcn_exp2f(a1[r] - ua); sa += a0[r] + a1[r];
                                  b0[r] = __builtin_amdgcn_exp2f(b0[r] - ub); b1[r] = __builtin_amdgcn_exp2f(b1[r] - ub); sb += b0[r] + b1[r]; }
    lA += sa; lB += sb;
    const unsigned w0 = cvt4_fp8(a0[0], a0[1], a0[2], a0[3]), w1 = cvt4_fp8(a1[0], a1[1], a1[2], a1[3]);
    const unsigned v0 = cvt4_fp8(b0[0], b0[1], b0[2], b0[3]), v1 = cvt4_fp8(b1[0], b1[1], b1[2], b1[3]);
    pa = (long)(((unsigned long long)w1 << 32) | w0); pb = (long)(((unsigned long long)v1 << 32) | v0);
}

__device__ __forceinline__ void win_task(Frame& F, int task) {
    const int bg = task >> 9, t0 = (task & 511) * 16, b = bg >> 1, g = bg & 1, fr = F.lane & 15, fq = F.lane >> 4, t = t0 + fr;
    const bf16* Kp = (const bf16*)(F.ws + AR_NKV) + (size_t)((2 * 2 + 0) * 4 + bg) * SEQ * 64;
    const bf16* VT = (const bf16*)(F.ws + AR_NKV) + (size_t)((2 * 2 + 1) * 4 + bg) * SEQ * 64;
    const bf16* Q = (const bf16*)(F.ws + AR_NQ) + ((size_t)(b * 8 + g * 4) * SEQ + t) * 64;
    const LAS float* bl = (const LAS float*)(F.lds + BIASL_OFF) + (g * 4) * 132;
    KF qf[4]; f32x4 O[4][4]; float m[4], l[4];
#pragma unroll
    for (int z = 0; z < 4; ++z) { qf[z] = ld_kf(Q + (size_t)z * SEQ * 64, fq); m[z] = NEG_INF; l[z] = 0.f;
#pragma unroll
        for (int dt = 0; dt < 4; ++dt) O[z][dt] = (f32x4){0.f, 0.f, 0.f, 0.f}; }
    int kstart = t0 - 511; kstart = kstart < 0 ? 0 : (kstart & ~31);
    KF ka = ld_kt(Kp, kstart, F.lane), kb = ld_kt(Kp, kstart + 16, F.lane);
    bf16x8 vf[4];
#pragma unroll
    for (int dt = 0; dt < 4; ++dt) vf[dt] = ld_vt(VT, kstart, dt, F.lane);
#pragma clang loop unroll(disable)
    for (int k0 = kstart; k0 <= t0 + 15; k0 += 32) {
        const int kn = (k0 + 32 <= t0 + 15) ? k0 + 32 : k0;
        const KF nka = ld_kt(Kp, kn, F.lane), nkb = ld_kt(Kp, kn + 16, F.lane);
        bf16x8 nvf[4];
#pragma unroll
        for (int dt = 0; dt < 4; ++dt) nvf[dt] = ld_vt(VT, kn, dt, F.lane);
        const int d0 = t - (k0 + 4 * fq);
        const bool interior = (k0 + 31 + 128 <= t0) && (t0 + 15 - k0 < 512);
        f32x4 s0[4], s1[4]; bf16x8 pf[4];
#pragma unroll
        for (int z = 0; z < 4; ++z) { s0[z] = qk16(ka, qf[z]); s1[z] = qk16(kb, qf[z]); }
        if (interior) {
#pragma unroll
            for (int z = 0; z < 4; ++z) { const float bb = bl[z * 132 + 128];
#pragma unroll
                for (int r = 0; r < 4; ++r) { s0[z][r] = s0[z][r] * QK_C + bb; s1[z][r] = s1[z][r] * QK_C + bb; } }
        } else {
#pragma unroll
            for (int z = 0; z < 4; ++z)
#pragma unroll
                for (int r = 0; r < 4; ++r) {
                    const int da = d0 - r, db = d0 - 16 - r;
                    const int ia = da < 0 ? 0 : (da > 128 ? 128 : da), ib = db < 0 ? 0 : (db > 128 ? 128 : db);
                    s0[z][r] = ((unsigned)da < 512u) ? s0[z][r] * QK_C + bl[z * 132 + ia] : NEG_INF;
                    s1[z][r] = ((unsigned)db < 512u) ? s1[z][r] * QK_C + bl[z * 132 + ib] : NEG_INF;
                }
        }
#pragma unroll
        for (int z = 0; z < 4; ++z) pf[z] = osm_step(s0[z], s1[z], m[z], l[z], O[z]);
#pragma unroll
        for (int z = 0; z < 4; ++z)
#pragma unroll
            for (int dt = 0; dt < 4; ++dt) O[z][dt] = __builtin_amdgcn_mfma_f32_16x16x32_bf16(vf[dt], pf[z], O[z][dt], 0, 0, 0);
        ka = nka; kb = nkb;
#pragma unroll
        for (int dt = 0; dt < 4; ++dt) vf[dt] = nvf[dt];
    }
    const float* gt = (const float*)(F.ws + AR_GATES) + (size_t)(b * SEQ + t) * 24 + (g * 4) * 3 + 2;
    float* op = (float*)(F.ws + AR_OWIN) + (size_t)(b * SEQ + t) * 512 + (g * 4) * 64 + 4 * fq;
#pragma unroll
    for (int z = 0; z < 4; ++z) { const float sc = gt[z * 3] / fmaxf(fq_sum(l[z]), 1e-30f);
#pragma unroll
        for (int dt = 0; dt < 4; ++dt) *(f32x4*)(op + z * 64 + 16 * dt) = O[z][dt] * sc; }
}


__device__ __forceinline__ void sb_task(Frame& F, int task) {
    const int bh = task >> 9, t0 = (task & 511) * 16, fr = F.lane & 15, fq = F.lane >> 4, t = t0 + fr;
    const bf16* Kp = (const bf16*)(F.ws + AR_SBK) + (size_t)bh * SEQ * 64;
    const bf16* VT = (const bf16*)(F.ws + AR_SBV) + (size_t)bh * SEQ * 64;
    const KF qf = ld_kf((const bf16*)(F.ws + AR_SBQ) + ((size_t)bh * SEQ + t) * 64, fq);
    f32x4 O[4];
#pragma unroll
    for (int dt = 0; dt < 4; ++dt) O[dt] = (f32x4){0.f, 0.f, 0.f, 0.f};
    float carry = 0.f;
    const bool g1 = (fq ^ 1) > fq, g2 = (fq ^ 2) > fq, g3 = (fq ^ 3) > fq;
    const int kfirst = (t0 + 14) & ~31;
    KF ka = ld_kt(Kp, kfirst, F.lane), kb = ld_kt(Kp, kfirst + 16, F.lane);
    bf16x8 vf[4];
#pragma unroll
    for (int dt = 0; dt < 4; ++dt) vf[dt] = ld_vt(VT, kfirst, dt, F.lane);
#pragma clang loop unroll(disable)
    for (int k0 = kfirst; k0 >= 0; k0 -= 32) {
        const int kn = k0 >= 32 ? k0 - 32 : k0;
        const KF nka = ld_kt(Kp, kn, F.lane), nkb = ld_kt(Kp, kn + 16, F.lane);
        bf16x8 nvf[4];
#pragma unroll
        for (int dt = 0; dt < 4; ++dt) nvf[dt] = ld_vt(VT, kn, dt, F.lane);
        f32x4 z0 = qk16(ka, qf), z1 = qk16(kb, qf), L0, L1;
        const int key0 = k0 + 4 * fq;
#pragma unroll
        for (int r = 0; r < 4; ++r) {
            z0[r] *= QK_C; z1[r] *= QK_C;
            const float la = fmaxf(z0[r], 0.f) + __builtin_amdgcn_logf(1.f + __builtin_amdgcn_exp2f(-fabsf(z0[r])));
            const float lb = fmaxf(z1[r], 0.f) + __builtin_amdgcn_logf(1.f + __builtin_amdgcn_exp2f(-fabsf(z1[r])));
            L0[r] = (key0 + r < t) ? la : 0.f;
            L1[r] = (key0 + 16 + r < t) ? lb : 0.f;
        }
        f32x4 c0, c1;
        c1[3] = L1[3]; c1[2] = c1[3] + L1[2]; c1[1] = c1[2] + L1[1]; c1[0] = c1[1] + L1[0];
        c0[3] = L0[3]; c0[2] = c0[3] + L0[2]; c0[1] = c0[2] + L0[1]; c0[0] = c0[1] + L0[0];
        const float a1 = xor16f(c1[0]), a2 = xor32f(c1[0]), a3 = xor32f(a1);
        const float b1 = xor16f(c0[0]), b2 = xor32f(c0[0]), b3 = xor32f(b1);
        const float tot1 = c1[0] + a1 + a2 + a3, tot0 = c0[0] + b1 + b2 + b3;
        const float e1 = carry + (g1 ? a1 : 0.f) + (g2 ? a2 : 0.f) + (g3 ? a3 : 0.f);
        const float e0 = carry + tot1 + (g1 ? b1 : 0.f) + (g2 ? b2 : 0.f) + (g3 ? b3 : 0.f);
        f32x4 p0, p1;
#pragma unroll
        for (int r = 0; r < 4; ++r) {
            const float pa = __builtin_amdgcn_exp2f(z0[r] - (e0 + c0[r])), pb = __builtin_amdgcn_exp2f(z1[r] - (e1 + c1[r]));
            p0[r] = (key0 + r < t) ? pa : 0.f;
            p1[r] = (key0 + 16 + r < t) ? pb : 0.f;
        }
        carry += tot1 + tot0;
        const bf16x8 pf = pack_p(p0, p1);
#pragma unroll
        for (int dt = 0; dt < 4; ++dt) O[dt] = __builtin_amdgcn_mfma_f32_16x16x32_bf16(vf[dt], pf, O[dt], 0, 0, 0);
        if (__all(carry > 159.f)) break;
        ka = nka; kb = nkb;
#pragma unroll
        for (int dt = 0; dt < 4; ++dt) vf[dt] = nvf[dt];
    }
    float* op = (float*)(F.ws + AR_ORAW) + (size_t)((bh >> 3) * SEQ + t) * DM + (bh & 7) * 64 + 4 * fq;
#pragma unroll
    for (int dt = 0; dt < 4; ++dt) *(f32x4*)(op + 16 * dt) = O[dt];
}


__device__ __forceinline__ void nsa_task(Frame& F, int task) {
    const int bg = task >> 11, tq_ = task & 2047, tb = (2047 - tq_) * 4, b = bg >> 1,
                g = bg & 1, fr = F.lane & 15, fq = F.lane >> 4, tl = fr >> 2, z = fr & 3, t = tb + tl, hh = g * 4 + z;
    LAS float* imp = (LAS float*)(F.lds + RING_OFF + F.wave * 8192);
    LAS unsigned char* sel = (LAS unsigned char*)(F.lds + RING_OFF + F.wave * 8192 + 4224);
    const bf16* KC = (const bf16*)(F.ws + AR_KC) + (size_t)(0 * 4 + bg) * 512 * 64;
    const bf16* VCT = (const bf16*)(F.ws + AR_KC) + (size_t)(1 * 4 + bg) * 512 * 64;
    const bf16* KS = (const bf16*)(F.ws + AR_NKV) + (size_t)((1 * 2 + 0) * 4 + bg) * SEQ * 64;
    const bf16* VST = (const bf16*)(F.ws + AR_NKV) + (size_t)((1 * 2 + 1) * 4 + bg) * SEQ * 64;
    const bf16* Qg = (const bf16*)(F.ws + AR_NQ) + (size_t)(b * 8 + g * 4) * SEQ * 64;
    const float* gates = (const float*)(F.ws + AR_GATES);
    const LAS float* bl = (const LAS float*)(F.lds + BIASL_OFF) + hh * 132;
    for (int i = F.lane; i < 2 * 4 * 132; i += 64) imp[i] = 0.f;
    const KF qf = ld_kf(Qg + ((size_t)z * SEQ + t) * 64, fq);
    int nvis = t >= 31 ? ((t - 31) >> 4) + 1 : 0; nvis = nvis > NCMP ? NCMP : nvis;
    int nmax = (tb + 3) >= 31 ? ((tb + 3 - 31) >> 4) + 1 : 0; nmax = nmax > NCMP ? NCMP : nmax;
    const int dbase = t - 31 - 16 * (4 * fq);
    const float bfar = bl[128];
    float m = NEG_INF, l = 0.f;
    KF ka = ld_kt(KC, 0, F.lane), kb = ld_kt(KC, 16, F.lane);
#pragma clang loop unroll(disable)
    for (int n0 = 0; n0 < nmax; n0 += 32) {
        const int nn = n0 + 32 < nmax ? n0 + 32 : n0;
        const KF nka = ld_kt(KC, nn, F.lane), nkb = ld_kt(KC, nn + 16, F.lane);
        f32x4 s0 = qk16(ka, qf), s1 = qk16(kb, qf);
        ka = nka; kb = nkb;
        if (16 * (n0 + 31) + 31 + 128 <= tb) {
#pragma unroll
            for (int r = 0; r < 4; ++r) { s0[r] = s0[r] * QK_C + bfar; s1[r] = s1[r] * QK_C + bfar; }
        } else {
#pragma unroll
        for (int r = 0; r < 4; ++r) {
            const int na = n0 + 4 * fq + r, nb = na + 16, da = dbase - 16 * (n0 + r), db = da - 256;
            const int ia = da < 0 ? 0 : (da > 128 ? 128 : da), ib = db < 0 ? 0 : (db > 128 ? 128 : db);
            s0[r] = na < nvis ? s0[r] * QK_C + bl[ia] : NEG_INF;
            s1[r] = nb < nvis ? s1[r] * QK_C + bl[ib] : NEG_INF;
        }
        }
        float smax = fq_max(fmaxf(fmaxf(fmaxf(s0[0], s0[1]), fmaxf(s0[2], s0[3])), fmaxf(fmaxf(s1[0], s1[1]), fmaxf(s1[2], s1[3]))));
        const float mnew = fmaxf(m, smax), muse = (mnew == NEG_INF) ? 0.f : mnew;
        float ps = 0.f;
#pragma unroll
        for (int r = 0; r < 4; ++r) ps += __builtin_amdgcn_exp2f(s0[r] - muse) + __builtin_amdgcn_exp2f(s1[r] - muse);
        l = l * __builtin_amdgcn_exp2f(m - muse) + ps; m = mnew;
    }
    const float muse = (m == NEG_INF) ? 0.f : m, inv = 1.f / fmaxf(fq_sum(l), 1e-30f);
    f32x4 O[4];
#pragma unroll
    for (int dt = 0; dt < 4; ++dt) O[dt] = (f32x4){0.f, 0.f, 0.f, 0.f};
    LDS_WAIT();
    ka = ld_kt(KC, 0, F.lane); kb = ld_kt(KC, 16, F.lane);
    bf16x8 vc[4];
#pragma unroll
    for (int dt = 0; dt < 4; ++dt) vc[dt] = ld_vt(VCT, 0, dt, F.lane);
#pragma clang loop unroll(disable)
    for (int n0 = 0; n0 < nmax; n0 += 32) {
        const int nn = n0 + 32 < nmax ? n0 + 32 : n0;
        const KF nka = ld_kt(KC, nn, F.lane), nkb = ld_kt(KC, nn + 16, F.lane);
        bf16x8 nvc[4];
#pragma unroll
        for (int dt = 0; dt < 4; ++dt) nvc[dt] = ld_vt(VCT, nn, dt, F.lane);
        f32x4 s0 = qk16(ka, qf), s1 = qk16(kb, qf);
        ka = nka; kb = nkb;
        if (16 * (n0 + 31) + 31 + 128 <= tb) { const float bm = bfar - muse;
#pragma unroll
            for (int r = 0; r < 4; ++r) { s0[r] = __builtin_amdgcn_exp2f(s0[r] * QK_C + bm) * inv; s1[r] = __builtin_amdgcn_exp2f(s1[r] * QK_C + bm) * inv; }
        } else {
#pragma unroll
        for (int r = 0; r < 4; ++r) {
            const int na = n0 + 4 * fq + r, nb = na + 16, da = dbase - 16 * (n0 + r), db = da - 256;
            const int ia = da < 0 ? 0 : (da > 128 ? 128 : da), ib = db < 0 ? 0 : (db > 128 ? 128 : db);
            s0[r] = na < nvis ? __builtin_amdgcn_exp2f(s0[r] * QK_C + bl[ia] - muse) * inv : 0.f;
            s1[r] = nb < nvis ? __builtin_amdgcn_exp2f(s1[r] * QK_C + bl[ib] - muse) * inv : 0.f;
        }
        }
        const bf16x8 pf = pack_p(s0, s1);
#pragma unroll
        for (int dt = 0; dt < 4; ++dt) { O[dt] = __builtin_amdgcn_mfma_f32_16x16x32_bf16(vc[dt], pf, O[dt], 0, 0, 0); vc[dt] = nvc[dt]; }
        float x0 = (s0[0] + s0[1]) + (s0[2] + s0[3]), y0 = s0[3], x1 = (s1[0] + s1[1]) + (s1[2] + s1[3]), y1 = s1[3];
        x0 += quad_x1(x0); x0 += quad_x2(x0); y0 += quad_x1(y0); y0 += quad_x2(y0);
        x1 += quad_x1(x1); x1 += quad_x2(x1); y1 += quad_x1(y1); y1 += quad_x2(y1);
        if (z == 0) { LAS float* ip = imp + tl * 132 + (n0 >> 2) + fq;
            ip[0] = x0; ip[4] = x1; ip[528 + 1] = y0; ip[528 + 5] = y1; }
    }
    {
        const float gc = gates[(size_t)(b * SEQ + t) * 24 + hh * 3 + 0];
        const float* ow = (const float*)(F.ws + AR_OWIN) + (size_t)(b * SEQ + t) * 512 + hh * 64 + 4 * fq;
        float* op = (float*)(F.ws + AR_ORAW) + (size_t)(b * SEQ + t) * DM + 512 + hh * 64 + 4 * fq;
#pragma unroll
        for (int dt = 0; dt < 4; ++dt) *(f32x4*)(op + 16 * dt) = O[dt] * gc + *(const f32x4*)(ow + 16 * dt);
    }
    LDS_WAIT();
    const int cur = tb >> 6;
    if (cur <= 15) { if (z == 0 && fq == 0) { for (int j = 0; j <= cur; ++j) sel[tl * 16 + j] = (unsigned char)j; } }
    else {
        const int c16 = z + 4 * fq; float v[8];
#pragma unroll
        for (int i = 0; i < 8; ++i) { const int j = c16 * 8 + i; v[i] = (j >= 1 && j <= cur - 2) ? imp[tl * 132 + j] + imp[528 + tl * 132 + j] : -1.f; }
        if (c16 == 0) { sel[tl * 16 + 0] = 0; sel[tl * 16 + 14] = (unsigned char)cur; sel[tl * 16 + 15] = (unsigned char)(cur - 1); }
#pragma clang loop unroll(disable)
        for (int it = 0; it < 13; ++it) {
            float bv = v[0]; int bj = c16 * 8;
#pragma unroll
            for (int i = 1; i < 8; ++i) if (v[i] > bv) { bv = v[i]; bj = c16 * 8 + i; }
#pragma unroll
            for (int sh = 0; sh < 4; ++sh) { float ov; int oj;
                if (sh == 0) { ov = quad_x1(bv); oj = __float_as_int(quad_x1(__int_as_float(bj))); }
                else if (sh == 1) { ov = quad_x2(bv); oj = __float_as_int(quad_x2(__int_as_float(bj))); }
                else if (sh == 2) { ov = xor16f(bv); oj = __float_as_int(xor16f(__int_as_float(bj))); }
                else { ov = xor32f(bv); oj = __float_as_int(xor32f(__int_as_float(bj))); }
                if (ov > bv || (ov == bv && oj < bj)) { bv = ov; bj = oj; } }
#pragma unroll
            for (int i = 0; i < 8; ++i) if (c16 * 8 + i == bj) v[i] = -2.f;
            if (c16 == 0) sel[tl * 16 + 1 + it] = (unsigned char)bj;
        }
    }
    asm volatile("s_waitcnt vmcnt(0) lgkmcnt(0)" ::: "memory");
    LAS unsigned* msk = (LAS unsigned*)(F.lds + RING_OFF + F.wave * 8192 + 4288);
    LAS unsigned char* ulist = (LAS unsigned char*)(F.lds + RING_OFF + F.wave * 8192 + 4352);
    if (z == 0 && fq == 0) {
        unsigned w0 = 0u, w1 = 0u, w2 = 0u, w3 = 0u; const int n = cur <= 15 ? cur + 1 : 16;
        for (int i = 0; i < n; ++i) { const int j = sel[tl * 16 + i]; const unsigned bit = 1u << (j & 31);
            w0 |= (j >> 5) == 0 ? bit : 0u; w1 |= (j >> 5) == 1 ? bit : 0u; w2 |= (j >> 5) == 2 ? bit : 0u; w3 |= (j >> 5) == 3 ? bit : 0u; }
        msk[tl * 4 + 0] = w0; msk[tl * 4 + 1] = w1; msk[tl * 4 + 2] = w2; msk[tl * 4 + 3] = w3;
    }
    LDS_WAIT();
    const unsigned U0 = __builtin_amdgcn_readfirstlane(msk[0] | msk[4] | msk[8] | msk[12]), U1 = __builtin_amdgcn_readfirstlane(msk[1] | msk[5] | msk[9] | msk[13]);
    const unsigned U2 = __builtin_amdgcn_readfirstlane(msk[2] | msk[6] | msk[10] | msk[14]), U3 = __builtin_amdgcn_readfirstlane(msk[3] | msk[7] | msk[11] | msk[15]);
    const int c0n = __builtin_popcount(U0), c1n = __builtin_popcount(U1), c2n = __builtin_popcount(U2), nU = c0n + c1n + c2n + __builtin_popcount(U3);
    {   const int hi = F.lane >> 5, bb = F.lane & 31; const unsigned lowm = (1u << bb) - 1u;
        const unsigned wa = hi ? U1 : U0, wb = hi ? U3 : U2;
        if ((wa >> bb) & 1u) ulist[(hi ? c0n : 0) + __builtin_popcount(wa & lowm)] = (unsigned char)F.lane;
        if ((wb >> bb) & 1u) ulist[c0n + c1n + (hi ? c2n : 0) + __builtin_popcount(wb & lowm)] = (unsigned char)(64 + F.lane);
    }
    LDS_WAIT();
    const unsigned char* KS8 = (const unsigned char*)KS; const unsigned char* VS8 = (const unsigned char*)VST;
    long q8lo, q8hi;
    {   const u32x4 a = __builtin_bit_cast(u32x4, qf.lo), c = __builtin_bit_cast(u32x4, qf.hi);
        const unsigned l0 = cvt4_fp8(__uint_as_float(a.x << 16), __uint_as_float(a.x & 0xffff0000u), __uint_as_float(a.y << 16), __uint_as_float(a.y & 0xffff0000u));
        const unsigned l1 = cvt4_fp8(__uint_as_float(a.z << 16), __uint_as_float(a.z & 0xffff0000u), __uint_as_float(a.w << 16), __uint_as_float(a.w & 0xffff0000u));
        const unsigned h0 = cvt4_fp8(__uint_as_float(c.x << 16), __uint_as_float(c.x & 0xffff0000u), __uint_as_float(c.y << 16), __uint_as_float(c.y & 0xffff0000u));
        const unsigned h1 = cvt4_fp8(__uint_as_float(c.z << 16), __uint_as_float(c.z & 0xffff0000u), __uint_as_float(c.w << 16), __uint_as_float(c.w & 0xffff0000u));
        q8lo = (long)(((unsigned long long)l1 << 32) | l0); q8hi = (long)(((unsigned long long)h1 << 32) | h0); }
    struct SelStep { u32x4 k[2]; u32x4 v[2]; };
    const int l8 = fq * 256 + fr * 16;
#define SEL_LOADK(B, k0_) do { const int _k0 = (k0_); B.k[0] = *(const u32x4*)(KS8 + (size_t)(_k0 >> 4) * 1024 + l8); B.k[1] = *(const u32x4*)(KS8 + (size_t)((_k0 >> 4) + 1) * 1024 + l8); } while (0)
#define SEL_LOADV(V, k0_) do { const int _k0 = (k0_); V[0] = *(const u32x4*)(VS8 + (size_t)(_k0 >> 5) * 2048 + l8); V[1] = *(const u32x4*)(VS8 + (size_t)(_k0 >> 5) * 2048 + 1024 + l8); } while (0)
#define U2L(lo_, hi_) ((long)(((unsigned long long)(hi_) << 32) | (unsigned long long)(lo_)))
#define QK8(KK) __builtin_amdgcn_mfma_f32_16x16x32_fp8_fp8(U2L(KK.z, KK.w), q8hi, __builtin_amdgcn_mfma_f32_16x16x32_fp8_fp8(U2L(KK.x, KK.y), q8lo, (f32x4){0.f, 0.f, 0.f, 0.f}, 0, 0, 0), 0, 0, 0)
#define SEL_LOGITS(B, k0_, cv_, s0, s1) do { s0 = QK8(B.k[0]); s1 = QK8(B.k[1]); \
        if ((k0_) + 31 + 128 <= tb) { const float bb_ = (cv_) ? bfar : NEG_INF; _Pragma("unroll") for (int r = 0; r < 4; ++r) { s0[r] = s0[r] * QK_C + bb_; s1[r] = s1[r] * QK_C + bb_; } } \
        else { const int d0 = t - ((k0_) + 4 * fq); \
            _Pragma("unroll") for (int r = 0; r < 4; ++r) { const int da = d0 - r, db = d0 - 16 - r; \
                const int ia = da < 0 ? 0 : (da > 128 ? 128 : da), ib = db < 0 ? 0 : (db > 128 ? 128 : db); \
                s0[r] = ((cv_) && da >= 0) ? s0[r] * QK_C + bl[ia] : NEG_INF; s1[r] = ((cv_) && db >= 0) ? s1[r] * QK_C + bl[ib] : NEG_INF; } } } while (0)
#define SEL_K0(q_, ka_, kb_, va_, vb_) do { const int _p = (q_) >> 1, _h = (q_) & 1; const int _ja = __builtin_amdgcn_readfirstlane((int)ulist[2 * _p]); \
        const bool _hb = 2 * _p + 1 < nU; const int _jb = _hb ? __builtin_amdgcn_readfirstlane((int)ulist[2 * _p + 1]) : _ja; \
        ka_ = 64 * _ja + 32 * _h; kb_ = 64 * _jb + 32 * _h; va_ = ((msk[tl * 4 + (_ja >> 5)] >> (_ja & 31)) & 1u) != 0u; vb_ = _hb && (((msk[tl * 4 + (_jb >> 5)] >> (_jb & 31)) & 1u) != 0u); } while (0)
#define PV8(OO, VV, PP) do { OO[0] = __builtin_amdgcn_mfma_f32_16x16x32_fp8_fp8(U2L(VV[0].x, VV[0].y), PP, OO[0], 0, 0, 0); OO[1] = __builtin_amdgcn_mfma_f32_16x16x32_fp8_fp8(U2L(VV[0].z, VV[0].w), PP, OO[1], 0, 0, 0); \
        OO[2] = __builtin_amdgcn_mfma_f32_16x16x32_fp8_fp8(U2L(VV[1].x, VV[1].y), PP, OO[2], 0, 0, 0); OO[3] = __builtin_amdgcn_mfma_f32_16x16x32_fp8_fp8(U2L(VV[1].z, VV[1].w), PP, OO[3], 0, 0, 0); } while (0)
#define SEL_STEP(CA_, CB_, NA_, NB_, q_) do { int na0 = ka0, nb0 = kb0; bool nva = cva, nvb = cvb; if ((q_) + 1 < nstep) SEL_K0((q_) + 1, na0, nb0, nva, nvb); \
        SEL_LOADK(NA_, na0); SEL_LOADK(NB_, nb0); SEL_LOADV(NA_.v, na0); SEL_LOADV(NB_.v, nb0); \
        f32x4 sa0, sa1, sb0, sb1; SEL_LOGITS(CA_, ka0, cva, sa0, sa1); SEL_LOGITS(CB_, kb0, cvb, sb0, sb1); \
        long pa, pb; osm_step8x2(sa0, sa1, mA, lA, OA, sb0, sb1, mB, lB, OB, pa, pb); \
        PV8(OA, CA_.v, pa); PV8(OB, CB_.v, pb); \
        ka0 = na0; kb0 = nb0; cva = nva; cvb = nvb; } while (0)
    {
        const int nstep = 2 * ((nU + 1) >> 1);
        float mA = NEG_INF, lA = 0.f, mB = NEG_INF, lB = 0.f; f32x4 OA[4], OB[4];
#pragma unroll
        for (int dt = 0; dt < 4; ++dt) { OA[dt] = (f32x4){0.f, 0.f, 0.f, 0.f}; OB[dt] = (f32x4){0.f, 0.f, 0.f, 0.f}; }
        SelStep XA, XB, YA, YB; int ka0, kb0; bool cva, cvb;
        SEL_K0(0, ka0, kb0, cva, cvb); SEL_LOADK(XA, ka0); SEL_LOADK(XB, kb0); SEL_LOADV(XA.v, ka0); SEL_LOADV(XB.v, kb0);
#pragma clang loop unroll(disable)
        for (int q = 0; q < nstep; q += 2) { SEL_STEP(XA, XB, YA, YB, q); SEL_STEP(YA, YB, XA, XB, q + 1); }
        const float mm = fmaxf(mA, mB), mu = (mm == NEG_INF) ? 0.f : mm, fa = __builtin_amdgcn_exp2f(mA - mu), fb = __builtin_amdgcn_exp2f(mB - mu);
        const float lt = fq_sum(lA * fa + lB * fb);
        const float sc = gates[(size_t)(b * SEQ + t) * 24 + hh * 3 + 1] / fmaxf(lt, 1e-30f);
        float* op = (float*)(F.ws + AR_ORAW) + (size_t)(b * SEQ + t) * DM + 512 + hh * 64 + 4 * fq;
#pragma unroll
        for (int dt = 0; dt < 4; ++dt) { const f32x4 prev = *(const f32x4*)(op + 16 * dt); *(f32x4*)(op + 16 * dt) = prev + (OA[dt] * fa + OB[dt] * fb) * sc; }
    }
#undef U2L
#undef QK8
#undef PV8
#undef SEL_LOADK
#undef SEL_LOADV
#undef SEL_LOGITS
#undef SEL_K0
#undef SEL_STEP
    LDS_WAIT();
}

constexpr int NPH_L = 9, NPHASES = 2 + 2 * NPH_L;

#define IN(k) (lo <= (k) && (k) < hi)
#if MK_SINGLE
#define SEAM(k) do { if (IN(k) && IN((k) + 1)) xcd_barrier(bar); } while (0)
#else
#define SEAM(k) do { } while (0)
#endif
template <int layer>
__device__ __forceinline__ void layer_body(Frame& F, const Args& args, const XcdBarrier& bar, const int lo, const int hi) {
        const int pb = 2 + layer * NPH_L;
#ifndef NO_GEMM
        if (IN(pb + 0)) {
            pg8::Gemm g{(const bf16*)(args.ws + WS_H), (const bf16*)(args.ws + WS_WIN) + (size_t)layer * NPROJ * DM, T, NPROJ, DM};
            pg8::ProjOrder S; S.init(T, NPROJ, F.G, (int)blockIdx.x);
            pg8::EpiProj E{(bf16*)(args.ws + AR_SBQ), (float*)(args.ws + AR_GATES)};
            pg8::gemm_phase<pg8::EpiProj, pg8::ProjOrder, true, 0, true>(F.lds + RING_OFF, g, nullptr, S, E);
        }
#endif
        SEAM(pb + 0);
        if (IN(pb + 1)) {
            if (F.vcu < 16) {
                pg8::Gemm g{(const bf16*)(args.ws + AR_NKV), (const bf16*)(args.ws + WS_CW1) + (size_t)layer * 2 * 256 * 2048, 4096, 512, 2048};
                pg8::CmpOrder S{F.G, F.vcu};
                pg8::EpiCmpHid E{(bf16*)(args.ws + AR_CHID), (const float*)(args.ws + WS_CBIAS) + (size_t)layer * 2 * 256};
                pg8::gemm_phase<pg8::EpiCmpHid, pg8::CmpOrder, false, 2>(F.lds + RING_OFF, g, nullptr, S, E);
                asm volatile("s_waitcnt vmcnt(0)" ::: "memory"); __syncthreads();
                cmp_out_unit(F, layer, F.vcu);
            }
#ifndef NO_WIN
            if (F.G == 256) {
                const int wv = F.vcu * NWAVES + F.wave;
                if (wv < 128) win_task(F, ((wv >> 5) << 9) | (wv & 31));
                else { const int r = wv - 128; win_task(F, ((r / 480) << 9) | (32 + r % 480)); }
            } else { for (int task = F.vcu * NWAVES + F.wave; task < 2048; task += F.G * NWAVES) win_task(F, task); }
#endif
#ifndef NO_SB
            {
                const int nw = (F.G - 16) * NWAVES, per = nw > 0 ? 8192 / nw : 0, nstat = per * nw;
                if (F.vcu >= 16) { for (int k = 0; k < per; ++k) sb_task(F, (F.vcu - 16) * NWAVES + F.wave + k * nw); }
                unsigned* qs = (unsigned*)(args.ws + WS_CTL) + CW_QUEUE + 128 + layer * 64;
                for (;;) {
                    unsigned q = 0; if (F.lane == 0) q = __hip_atomic_fetch_add(qs, 1u, __ATOMIC_RELAXED, __HIP_MEMORY_SCOPE_AGENT);
                    q = __builtin_amdgcn_readfirstlane(q);
                    if (nstat + q >= 8192u) break;
                    sb_task(F, nstat + (int)q);
                }
            }
#endif
        }
        SEAM(pb + 1);
#ifndef NO_NSA
        if (IN(pb + 2)) {
            unsigned* qh = (unsigned*)(args.ws + WS_CTL) + CW_QUEUE + layer * 64;
            for (;;) {
                unsigned q = 0; if (F.lane == 0) q = __hip_atomic_fetch_add(qh, 1u, __ATOMIC_RELAXED, __HIP_MEMORY_SCOPE_AGENT);
                q = __builtin_amdgcn_readfirstlane(q);
                if (q >= 8192u) break;
                nsa_task(F, (int)q);
            }
        }
#endif
        SEAM(pb + 2);
        if (IN(pb + 3)) { phase_merge(F, layer); }
        SEAM(pb + 3);
#ifndef NO_GEMM
        if (IN(pb + 4)) {
            pg8::Gemm g{(const bf16*)(args.ws + WS_H), (const bf16*)(args.ws + WS_WOUT) + (size_t)layer * DM * DM, T, DM, DM};
            pg8::StaticOrder S; S.init(T, DM, F.G, (int)blockIdx.x);
            pg8::EpiOutBf16 E{(bf16*)(args.ws + AR_M), DM};
            pg8::gemm_phase<pg8::EpiOutBf16, pg8::StaticOrder, false, 0>(F.lds + RING_OFF, g, nullptr, S, E);
        }
#endif
        SEAM(pb + 4);
#ifndef NO_THIN
        if (IN(pb + 5)) { phase_post_mix(F, layer); }
#endif
        SEAM(pb + 5);
#ifndef NO_GEMM
        if (IN(pb + 6)) {
            if (layer == 0) {
                pg8::Gemm g{(const bf16*)(args.ws + WS_H), (const bf16*)(args.ws + WS_FGU), T, 2 * DFF, DM};
                pg8::StaticOrder S; S.init(T, 2 * DFF, F.G, (int)blockIdx.x);
                pg8::EpiSwiglu E{(bf16*)(args.ws + AR_FHID), DFF, DFF / 128};
                pg8::gemm_phase<pg8::EpiSwiglu, pg8::StaticOrder, true, 0>(F.lds + RING_OFF, g, nullptr, S, E);
            } else {
                moe_table_build(F); const LAS int* tbl = (const LAS int*)(F.lds + MOETBL_OFF);
#define NTL(e) __builtin_amdgcn_readfirstlane(tbl[16 + (e)])
#define CNL(e) __builtin_amdgcn_readfirstlane(tbl[8 + (e)])
                pg8::Gemm g{(const bf16*)(args.ws + WS_H), (const bf16*)(args.ws + WS_MGU), MOE_ROWS, NE * 2 * DFE, DM};
                pg8::MoeOrder S{NTL(0), NTL(1), NTL(2), NTL(3), NTL(4), NTL(5), NTL(6), NTL(7), 2 * DFE / 256, F.G, (int)blockIdx.x, CNL(0), CNL(1), CNL(2), CNL(3), CNL(4), CNL(5), CNL(6), CNL(7)};
                pg8::EpiSwiglu E{(bf16*)(args.ws + AR_HIDM), DFE, DFE / 128};
                pg8::gemm_phase<pg8::EpiSwiglu, pg8::MoeOrder, true, 1>(F.lds + RING_OFF, g, (const int*)(args.ws + AR_ROWTOK), S, E);
            }
        }
#endif
        SEAM(pb + 6);
#ifndef NO_GEMM
        if (IN(pb + 7)) {
            if (layer == 0) {
                pg8::Gemm g{(const bf16*)(args.ws + AR_FHID), (const bf16*)(args.ws + WS_FD), T, DM, DFF};
                pg8::StaticOrder S; S.init(T, DM, F.G, (int)blockIdx.x);
                pg8::EpiOutBf16 E{(bf16*)(args.ws + AR_FOUT), DM};
                pg8::gemm_phase<pg8::EpiOutBf16, pg8::StaticOrder, false, 0>(F.lds + RING_OFF, g, nullptr, S, E);
            } else {
                moe_table_build(F); const LAS int* tbl = (const LAS int*)(F.lds + MOETBL_OFF);
                pg8::Gemm g{(const bf16*)(args.ws + AR_HIDM), (const bf16*)(args.ws + WS_MD), MOE_ROWS, NE * DM, DFE};
                const int nfull = __builtin_amdgcn_readfirstlane(tbl[24]), nS = __builtin_amdgcn_readfirstlane(tbl[25]);
                pg8::MoeDownOrder S{NTL(0), NTL(1), NTL(2), NTL(3), NTL(4), NTL(5), NTL(6), NTL(7), DM / 256, F.G, (int)blockIdx.x, nfull, nS, DFE / 64};
                pg8::EpiMoeDown E{(bf16*)(args.ws + WS_Y), (bf16*)(args.ws + WS_YPART), nfull * 256};
                pg8::gemm_phase<pg8::EpiMoeDown, pg8::MoeDownOrder, true, 0>(F.lds + RING_OFF, g, nullptr, S, E);
            }
        }
#endif
        SEAM(pb + 7);
#ifndef NO_THIN
        if (IN(pb + 8)) { phase_post_ffn(F, layer); }
#endif
        SEAM(pb + 8);

}
__global__ void __launch_bounds__(NTHR, 2) mega(Args args) {
    extern __shared__ __attribute__((aligned(16))) unsigned char lds_raw[];
    Frame F;
    F.lds = (LAS unsigned char*)lds_raw; F.a = &args; F.ws = args.ws;
    F.tid = threadIdx.x; F.lane = F.tid & 63; F.wave = __builtin_amdgcn_readfirstlane(F.tid >> 6);
    F.G = gridDim.x; { const int bx = blockIdx.x; F.vcu = (F.G % 8 == 0) ? (bx % 8) * (F.G / 8) + bx / 8 : bx; }
    if (F.tid < 4) ((LAS unsigned*)(F.lds + LDSCTL_OFF))[F.tid] = 0u;
    if (F.tid < 128) { const int n = F.tid; int bk = n;
        if (n >= 16) { bk = 16 + (int)(__log2f((float)n * (1.f / 16.f)) * (16.f / 3.f)); bk = bk > 31 ? 31 : bk; }
        ((LAS unsigned char*)(F.lds + LDSCTL_OFF + 64))[n] = (unsigned char)bk; }
    if (F.tid < 256) ((LAS float*)(F.lds + LDSCTL_OFF + 256))[F.tid] = args.in[2][F.tid];
    __syncthreads();
    for (int i = F.tid; i < 8 * 132; i += NTHR) { const int hh = i / 132, d = i % 132; const int bk = d < 128 ? (int)((LAS unsigned char*)(F.lds + LDSCTL_OFF + 64))[d] : 31;
        ((LAS float*)(F.lds + BIASL_OFF))[i] = ((LAS float*)(F.lds + LDSCTL_OFF + 256))[bk * 8 + hh] * 1.4426950408889634f; }
    __syncthreads();
    unsigned* ctl = (unsigned*)(args.ws + WS_CTL);
#if MK_SINGLE
    XcdBarrier bar = xcd_barrier_post(ctl + CW_BAR, (volatile LAS unsigned*)(F.lds + LDSCTL_OFF));
#else
    XcdBarrier bar; bar.bar = ctl; bar.x = 0; bar.st = nullptr;
#endif
    const int lo = args.ph_lo, hi = args.ph_hi;
#ifndef NO_PRO
    if (IN(0)) { phase_prologue(F); }
#endif
    SEAM(0);
    if (IN(1)) { phase_h0(F); } SEAM(1);
    layer_body<0>(F, args, bar, lo, hi);
    layer_body<1>(F, args, bar, lo, hi);
#undef IN
#undef SEAM
}


extern "C" void kernel_launch(void* const* d_in, const int* in_sizes, int n_in, void* d_out, int out_size, void* d_ws, size_t ws_size, hipStream_t stream) {
    static int grid = 0;
    if (grid == 0) {
        if (n_in != 27 || out_size != T * DM || ws_size < WS_END) { fprintf(stderr, "kernel_launch: unexpected problem (n_in %d out %d ws %zu)\n", n_in, out_size, ws_size); grid = -1; return; }
        int dev = 0, cus = 0, per_cu = 0;
        if (hipGetDevice(&dev) != hipSuccess || hipDeviceGetAttribute(&cus, hipDeviceAttributeMultiprocessorCount, dev) != hipSuccess) { grid = -1; return; }
        if (hipFuncSetAttribute((const void*)mega, hipFuncAttributeMaxDynamicSharedMemorySize, LDS_BYTES) != hipSuccess) { fprintf(stderr, "kernel_launch: hipFuncSetAttribute failed\n"); grid = -1; return; }
        if (hipOccupancyMaxActiveBlocksPerMultiprocessor(&per_cu, (const void*)mega, NTHR, LDS_BYTES) != hipSuccess || per_cu < 1) { fprintf(stderr, "kernel_launch: occupancy query says %d\n", per_cu); }
        (void)hipGetLastError();
        grid = cus;
    }
    if (grid < 0) return;
    if (hipMemsetAsync((char*)d_ws + WS_CTL, 0, CTL_ZERO_BYTES, stream) != hipSuccess) return;
    Args a{};
    for (int i = 0; i < 27; ++i) a.in[i] = (const float*)d_in[i];
    a.out = (float*)d_out; a.ws = (unsigned char*)d_ws;
#if MK_SINGLE
    a.ph_lo = 0; a.ph_hi = NPHASES;
    hipLaunchKernelGGL(mega, dim3(grid), dim3(NTHR), LDS_BYTES, stream, a);
#else
#ifndef MK_MAXPH
#define MK_MAXPH NPHASES
#endif
    for (int p = 0; p < MK_MAXPH; ++p) {
        a.ph_lo = p; a.ph_hi = p + 1;
        hipLaunchKernelGGL(mega, dim3(grid), dim3(NTHR), LDS_BYTES, stream, a);
    }
#endif
}
```

```cpp
#include <hip/hip_runtime.h>
#include <cstdint>
#include <cstdio>

#define GAS __attribute__((address_space(1)))
#define LAS __attribute__((address_space(3)))
typedef unsigned short bf16;
typedef short bf16x8 __attribute__((ext_vector_type(8)));
typedef float f32x4 __attribute__((ext_vector_type(4)));
typedef unsigned u32x4 __attribute__((ext_vector_type(4)));
typedef unsigned u32x2 __attribute__((ext_vector_type(2)));
typedef __bf16 bf16x2_t __attribute__((ext_vector_type(2)));

#ifndef MK_SINGLE
#define MK_SINGLE 1
#endif

constexpr int NB = 2, SEQ = 8192, T = NB * SEQ, DM = 1024, DH = 64;
constexpr int IN_COLS = 2840, NPROJ = 3072;
constexpr int NCMP = 511;
constexpr int DFF = 2816, DFE = 3584, NE = 8;
constexpr int MOE_ROWS = 34816;
constexpr float EPS = 1e-6f;
constexpr int NWAVES = 8, NTHR = 512;

constexpr size_t MiB = 1u << 20;
constexpr size_t WS_CTL = 0, CTL_ZERO_BYTES = 65536;
constexpr size_t WS_WIN = 1 * MiB;
constexpr size_t WS_WOUT = 13 * MiB;
constexpr size_t WS_CW1 = 17 * MiB;
constexpr size_t WS_CW2 = 21 * MiB;
constexpr size_t WS_CBIAS = 21 * MiB + 131072;
constexpr size_t WS_MOD = 524288;
constexpr size_t WS_FGU = 22 * MiB;
constexpr size_t WS_FD = 33 * MiB;
constexpr size_t WS_MGU = 39 * MiB;
constexpr size_t WS_MD = 151 * MiB;
constexpr size_t WS_H = 207 * MiB;
constexpr size_t WS_AR = 239 * MiB;
constexpr size_t AR_SBQ = WS_AR, AR_SBK = WS_AR + 16 * MiB, AR_SBV = WS_AR + 32 * MiB, AR_NQ = WS_AR + 48 * MiB, AR_NKV = WS_AR + 64 * MiB;
constexpr size_t AR_GATES = WS_AR + 88 * MiB, AR_KC = WS_AR + 90 * MiB, AR_ORAW = WS_AR + 92 * MiB, AR_OWIN = WS_AR + 156 * MiB;
constexpr size_t AR_CHID = WS_AR + 188 * MiB;
constexpr size_t AR_M = WS_AR;
constexpr size_t AR_FHID = WS_AR + 64 * MiB, AR_FOUT = WS_AR + 152 * MiB;
constexpr size_t AR_HIDM = WS_AR, AR_TOKINFO = WS_AR + 240 * MiB, AR_ROWTOK = WS_AR + 241 * MiB;
constexpr size_t WS_Y = 1 * MiB;
constexpr size_t WS_END = WS_AR + 242 * MiB;
constexpr size_t WS_YPART = 72 * MiB;
static_assert(WS_Y + (size_t)MOE_ROWS * 1024 * 4 <= WS_MD, "y overlay");
static_assert(WS_Y + (size_t)MOE_ROWS * 1024 * 2 <= WS_YPART && WS_YPART + (size_t)7 * 2048 * 1024 * 2 <= WS_MD, "y partials overlay");
static_assert(AR_HIDM + (size_t)MOE_ROWS * DFE * 2 <= AR_TOKINFO, "moe hidden");

constexpr int CW_BAR = 4096, CW_CNT = 8192, CW_QUEUE = 8448;

constexpr int RING_OFF = 0, RING_BYTES = 131072;
constexpr int LDSCTL_OFF = RING_BYTES;
constexpr int BIASL_OFF = LDSCTL_OFF + 1536;
constexpr int LDS_BYTES = 147456;

struct Args { const float* in[27]; float* out; unsigned char* ws; int ph_lo, ph_hi; };

typedef float f32x2_t __attribute__((ext_vector_type(2)));
__device__ __forceinline__ unsigned cvt_pk_bf16(float lo, float hi) { const f32x2_t v = {lo, hi}; const bf16x2_t b = __builtin_convertvector(v, bf16x2_t); return __builtin_bit_cast(unsigned, b); }
__device__ __forceinline__ float wave_sum(float v) {
    v += __uint_as_float(__builtin_amdgcn_update_dpp(0, __float_as_uint(v), 0xB1, 0xf, 0xf, true));
    v += __uint_as_float(__builtin_amdgcn_update_dpp(0, __float_as_uint(v), 0x4E, 0xf, 0xf, true));
    v += __uint_as_float(__builtin_amdgcn_update_dpp(0, __float_as_uint(v), 0x141, 0xf, 0xf, true));
    v += __uint_as_float(__builtin_amdgcn_update_dpp(0, __float_as_uint(v), 0x140, 0xf, 0xf, true));
    auto a = __builtin_amdgcn_permlane16_swap(__float_as_uint(v), __float_as_uint(v), false, false); v = __uint_as_float(a[0]) + __uint_as_float(a[1]);
    auto b = __builtin_amdgcn_permlane32_swap(__float_as_uint(v), __float_as_uint(v), false, false); return __uint_as_float(b[0]) + __uint_as_float(b[1]);
}


__host__ __device__ __forceinline__ size_t koff(int s, int d) { return (size_t)(s >> 4) * 1024 + (size_t)((d >> 5) * 512 + ((d >> 3) & 3) * 128 + (s & 15) * 8 + (d & 7)); }
__host__ __device__ __forceinline__ size_t voff(int s, int d) { return (size_t)(s >> 5) * 2048 + (size_t)((d >> 4) * 512 + ((s & 15) >> 2) * 128 + (d & 15) * 8 + ((s >> 4) & 1) * 4 + (s & 3)); }

__host__ __device__ __forceinline__ size_t k8off(int s, int d) { return (size_t)(s >> 4) * 1024 + (size_t)(((d >> 3) & 3) * 256 + (s & 15) * 16 + (d >> 5) * 8 + (d & 7)); }
__host__ __device__ __forceinline__ size_t v8off(int s, int d) { return (size_t)(s >> 5) * 2048 + (size_t)((d >> 5) * 1024 + ((s & 15) >> 2) * 256 + (d & 15) * 16 + ((d >> 4) & 1) * 8 + ((s >> 4) & 1) * 4 + (s & 3)); }
__device__ __forceinline__ unsigned cvt4_fp8(float a, float b, float c, float d) { int w = __builtin_amdgcn_cvt_pk_fp8_f32(a, b, 0, false); w = __builtin_amdgcn_cvt_pk_fp8_f32(c, d, w, true); return (unsigned)w; }

namespace pg8 {
constexpr int BM = 256, BK = 64, HALF = 128, HTB = HALF * BK * 2, NXCD = 8, WGM = 8;
__host__ __device__ __forceinline__ int lds_byte(int r, int c) { const int st = (r >> 4) * 2 + (c >> 5), rr = r & 15, cc = c & 31, ob = rr * 64 + cc * 2; return st * 1024 + (ob ^ (((ob >> 9) & 1) << 5)); }
__host__ __device__ __forceinline__ void stage_rc(int b, int& R, int& C) { const int st = b / 1024, sb = b % 1024, swz = sb ^ (((sb >> 9) & 1) << 5); R = (st >> 1) * 16 + swz / 64; C = (st & 1) * 32 + (swz % 64) / 2; }
__host__ __device__ __forceinline__ int perm32(int rho) { const int n = rho >> 4, i = rho & 15; return 8 * (i >> 2) + 4 * n + (i & 3); }
struct Unit { int pm, pn, ga, gl, k0, nt, part, sw; };
struct Gemm { const bf16* A; const bf16* Bt; int M, N, K; };
struct StaticOrder {
    static constexpr bool SPLIT = false;
    int nM, nN, nwg, G, c;
    __device__ void init(int M, int N, int G_, int c_) { nM = M / BM; nN = N / BM; nwg = nM * nN; G = G_; c = c_; }
    __device__ bool next(int i, Unit& u) const {
        const long L = (long)i * G + c; if (L >= nwg) return false;
        int wgid = (int)L; { const int q = nwg / NXCD, r = nwg % NXCD, xcd = wgid % NXCD, off = wgid / NXCD; wgid = (xcd < r ? xcd * (q + 1) : r * (q + 1) + (xcd - r) * q) + off; }
        const int nig = WGM * nN, gid = wgid / nig, fm = gid * WGM, gsz = (nM - fm) < WGM ? (nM - fm) : WGM;
        u.pm = fm + ((wgid % nig) % gsz); u.pn = (wgid % nig) / gsz; u.ga = 0; u.gl = 0; u.sw = 0; return true;
    }
};
struct ProjOrder : StaticOrder {
    __device__ bool next(int i, Unit& u) const { if (!StaticOrder::next(i, u)) return false; u.sw = (u.pn == 4 || u.pn == 5) ? 3 : ((u.pn == 9 || u.pn == 10) ? 2 : 0); return true; }
};
struct MoeOrder {
    static constexpr bool SPLIT = false;
    int nt0, nt1, nt2, nt3, nt4, nt5, nt6, nt7; int nN, G, c; int cn0, cn1, cn2, cn3, cn4, cn5, cn6, cn7;
    static __device__ __forceinline__ void block_map(int L, int nte, int nN, int& pml, int& pnl) {
        const int Gf = nte >> 3, rr = nte & 7, fullu = Gf * 8 * nN;
        if (L < fullu) { const int blk = L >> 5, ii = L & 31, cg = blk / Gf, rg = blk - cg * Gf; pml = rg * 8 + (ii & 7); pnl = cg * 4 + (ii >> 3); }
        else { const int Lr = L - fullu, q = Lr / rr; pml = Gf * 8 + (Lr - q * rr); pnl = q; }
    }
    __device__ bool next(int i, Unit& u) const {
        int L = i * G + c; int tb = 0, nte = nt0, cne = cn0, e = 0; bool done = false;
#define MOE_ADV(ntn, cnn) if (!done) { const int ue = nte * nN; if (L >= ue) { L -= ue; tb += nte; ++e; nte = ntn; cne = cnn; } else done = true; }
        MOE_ADV(nt1, cn1) MOE_ADV(nt2, cn2) MOE_ADV(nt3, cn3) MOE_ADV(nt4, cn4) MOE_ADV(nt5, cn5) MOE_ADV(nt6, cn6) MOE_ADV(nt7, cn7)
#undef MOE_ADV
        if (L >= nte * nN) return false;
        int pml, pnl; block_map(L, nte, nN, pml, pnl);
        u.pm = tb + pml; u.pn = e * nN + pnl; u.ga = e * 16384 - tb * 256; u.gl = tb * 256 + cne; u.sw = 0;
        return true;
    }
};

struct MoeDownOrder {
    static constexpr bool SPLIT = true;
    int nt0, nt1, nt2, nt3, nt4, nt5, nt6, nt7; int nN, G, c, nfull, S, ntk;
    __device__ bool next(int i, Unit& u) const {
        int L = i * G + c; int tb = 0, nte = nt0, e = 0; bool done = false;
        u.ga = 0; u.gl = 0; u.k0 = 0; u.nt = ntk; u.part = -1; u.sw = 0;
#define MOE_FE(x_) ((nfull - tb) < 0 ? 0 : ((nfull - tb) > (x_) ? (x_) : (nfull - tb)))
#define MOE_ADV(ntn) if (!done) { const int ue = MOE_FE(nte) * nN; if (L >= ue) { L -= ue; tb += nte; ++e; nte = ntn; } else done = true; }
        MOE_ADV(nt1) MOE_ADV(nt2) MOE_ADV(nt3) MOE_ADV(nt4) MOE_ADV(nt5) MOE_ADV(nt6) MOE_ADV(nt7)
#undef MOE_ADV
        { const int fe = MOE_FE(nte);
          if (L < fe * nN) { int pml, pnl; MoeOrder::block_map(L, fe, nN, pml, pnl); u.pm = tb + pml; u.pn = e * nN + pnl; return true; }
          L -= fe * nN; tb += nte; }
#undef MOE_FE
        const int ntail = tb - nfull;
        if (S <= 1 || L >= ntail * nN * S) return false;
        const int s = L % S, j = L / S, tile = nfull + j % ntail, pnl = j / ntail;
        int e2 = 0, te = nt0;
#define MOE_FIND(ntx) if (tile >= te) { ++e2; te += ntx; }
        MOE_FIND(nt1) MOE_FIND(nt2) MOE_FIND(nt3) MOE_FIND(nt4) MOE_FIND(nt5) MOE_FIND(nt6) MOE_FIND(nt7)
#undef MOE_FIND
        u.pm = tile; u.pn = e2 * nN + pnl; u.nt = ntk / S; u.k0 = s * (ntk / S) * (BK * 2); u.part = s;
        return true;
    }
};

template <class Epi, class Sched, bool ALIGN_EPI, int GATHER, bool SWAPV = false>
__device__ __forceinline__ void gemm_phase(LAS unsigned char* lds, const Gemm g, const int* rowidx, const Sched& S, const Epi& E) {
    const int tid = threadIdx.x, wid = __builtin_amdgcn_readfirstlane(tid >> 6), lane = tid & 63, wr = wid >> 2, wc = wid & 3, fr = lane & 15, fq = lane >> 4;
    const int K = g.K, nt = K / BK;
    int RA[2]; unsigned CA2[2], voffB[2];
#pragma unroll
    for (int i = 0; i < 2; ++i) { int R, C; stage_rc(tid * 16 + i * 8192, R, C); const int Rb = (R & ~31) + perm32(R & 31);
        RA[i] = R; CA2[i] = (unsigned)C * 2u; voffB[i] = (unsigned)(Rb * K + C) * 2u; }
    const unsigned rowbytes = GATHER == 2 ? 2048u : (unsigned)K * 2u;
    const size_t kstep = (size_t)(BK * 2);
    const size_t hstep = (size_t)HALF * K * 2;
    const size_t tstep = 2 * hstep;
    const unsigned ldsw = (unsigned)wid * 1024u;
    const int aoff = lds_byte(wr * 64 + fr, fq * 8), boff = lds_byte(wc * 32 + fr, fq * 8);
    const char* Abase = (const char*)g.A;
#define PG8_SA(b, h) (((b) * 2 + (h)) * HTB)
#define PG8_SB(b, h) ((4 + (b) * 2 + (h)) * HTB)
#define PG8_STAGE_B(bufoff, gbase) do { _Pragma("unroll") for (int _i = 0; _i < 2; ++_i) \
        __builtin_amdgcn_global_load_lds((const unsigned*)((const char*)(gbase) + voffB[_i]), (LAS unsigned*)(lds + (bufoff) + ldsw + _i * 8192), 16, 0, 0); } while (0)
#define PG8_STAGE_A(bufoff, GG, h, kb) do { _Pragma("unroll") for (int _i = 0; _i < 2; ++_i) \
        __builtin_amdgcn_global_load_lds((const unsigned*)(Abase + (size_t)(kb) + (size_t)GG[h][_i]), (LAS unsigned*)(lds + (bufoff) + ldsw + _i * 8192), 16, 0, 0); } while (0)
#define PG8_CALC_G(U_, GG) do { _Pragma("unroll") for (int _h = 0; _h < 2; ++_h) _Pragma("unroll") for (int _i = 0; _i < 2; ++_i) { \
        int _row = (U_).pm * BM + _h * HALF + RA[_i]; if (GATHER == 1) _row = _row < (U_).gl ? rowidx[_row + (U_).ga] : 0; if (GATHER == 2) { const int _n = _row & 511; _row = (_row & ~511) | (_n > 510 ? 510 : _n); } GG[_h][_i] = (unsigned)_row * rowbytes + CA2[_i] + (Sched::SPLIT ? (unsigned)(U_).k0 : 0u); } } while (0)
#define PG8_LDA(dst, b, h) do { _Pragma("unroll") for (int m = 0; m < 4; ++m) _Pragma("unroll") for (int k = 0; k < 2; ++k) dst[m][k] = *(const LAS bf16x8*)(lds + PG8_SA(b, h) + aoff + m * 2048 + k * 1024); } while (0)
#define PG8_LDB(dst, b, h) do { _Pragma("unroll") for (int n = 0; n < 2; ++n) _Pragma("unroll") for (int k = 0; k < 2; ++k) dst[n][k] = *(const LAS bf16x8*)(lds + PG8_SB(b, h) + boff + n * 2048 + k * 1024); } while (0)
#define PG8_MMA(ai, bj, At, Bt) do { __builtin_amdgcn_s_setprio(1); \
        if (SWAPV && (((SWC_) >> (bj)) & 1)) { _Pragma("unroll") for (int m = 0; m < 4; ++m) _Pragma("unroll") for (int n = 0; n < 2; ++n) _Pragma("unroll") for (int k = 0; k < 2; ++k) \
            acc[ai][bj][m][n] = __builtin_amdgcn_mfma_f32_16x16x32_bf16(At[m][k], Bt[n][k], acc[ai][bj][m][n], 0, 0, 0); } \
        else { _Pragma("unroll") for (int m = 0; m < 4; ++m) _Pragma("unroll") for (int n = 0; n < 2; ++n) _Pragma("unroll") for (int k = 0; k < 2; ++k) \
            acc[ai][bj][m][n] = __builtin_amdgcn_mfma_f32_16x16x32_bf16(Bt[n][k], At[m][k], acc[ai][bj][m][n], 0, 0, 0); } \
        __builtin_amdgcn_s_setprio(0); } while (0)
#define PG8_WAIT_V(n) asm volatile("s_waitcnt vmcnt(" #n ")" ::: "memory")
#define PG8_WAIT_L(n) asm volatile("s_waitcnt lgkmcnt(" #n ")" ::: "memory")
#define PG8_BAR __builtin_amdgcn_s_barrier()
#define PG8_SCHED __builtin_amdgcn_sched_barrier(0)
#define PG8_KLOOP() \
        for (int t = 0; t < cnt; t += 2) { \
            const bool last = (t == cnt - 2); \
            const size_t kb1 = (size_t)(t + 1) * kstep; \
            unsigned g2[2][2]; \
_Pragma("unroll") \
            for (int h = 0; h < 2; ++h) \
_Pragma("unroll") \
                for (int i = 0; i < 2; ++i) g2[h][i] = last ? gn[h][i] : gc[h][i]; \
            const size_t kb2 = last ? (size_t)0 : (size_t)(t + 2) * kstep, kb3 = kb2 + kstep; \
            const char* b2 = last ? nB : cB + (size_t)(t + 2) * kstep; const char* b3 = b2 + kstep; \
            PG8_LDB(B0, 0, 0); PG8_LDB(B1, 0, 1); PG8_SCHED; PG8_LDA(At, 0, 0); PG8_STAGE_A(PG8_SA(1, 1), gc, 1, kb1); \
            PG8_WAIT_V(8); PG8_WAIT_L(0); PG8_BAR; PG8_MMA(0, 0, At, B0); PG8_MMA(0, 1, At, B1); PG8_BAR; PG8_SCHED; \
            PG8_LDA(At, 0, 1); PG8_STAGE_B(PG8_SB(0, 0), b2); PG8_STAGE_B(PG8_SB(0, 1), b2 + hstep); PG8_STAGE_A(PG8_SA(0, 0), g2, 0, kb2); \
            PG8_WAIT_V(8); PG8_WAIT_L(0); PG8_BAR; PG8_MMA(1, 0, At, B0); PG8_MMA(1, 1, At, B1); PG8_BAR; PG8_SCHED; \
            PG8_LDB(B0, 1, 0); PG8_LDB(B1, 1, 1); PG8_SCHED; PG8_LDA(At, 1, 0); PG8_STAGE_A(PG8_SA(0, 1), g2, 1, kb2); \
            PG8_WAIT_V(8); PG8_WAIT_L(0); PG8_BAR; PG8_MMA(0, 0, At, B0); PG8_MMA(0, 1, At, B1); PG8_BAR; PG8_SCHED; \
            PG8_LDA(At, 1, 1); PG8_STAGE_B(PG8_SB(1, 0), b3); PG8_STAGE_B(PG8_SB(1, 1), b3 + hstep); PG8_STAGE_A(PG8_SA(1, 0), g2, 0, kb3); \
            PG8_WAIT_V(8); PG8_WAIT_L(0); PG8_BAR; PG8_MMA(1, 0, At, B0); PG8_MMA(1, 1, At, B1); PG8_BAR; PG8_SCHED; \
        }
    Unit cur, nxt; int ui = 0;
    if (!S.next(0, cur)) return;
    f32x4 acc[2][2][4][2];
#pragma unroll
    for (int a = 0; a < 2; ++a)
#pragma unroll
        for (int b = 0; b < 2; ++b)
#pragma unroll
            for (int m = 0; m < 4; ++m)
#pragma unroll
                for (int n = 0; n < 2; ++n) acc[a][b][m][n] = (f32x4){0.f, 0.f, 0.f, 0.f};
    bf16x8 At[4][2], B0[2][2], B1[2][2];
    unsigned gc[2][2], gn[2][2];
    PG8_CALC_G(cur, gc);
    const char* cB = (const char*)g.Bt + (size_t)cur.pn * tstep + (Sched::SPLIT ? (size_t)cur.k0 : (size_t)0);
    PG8_STAGE_B(PG8_SB(0, 0), cB); PG8_STAGE_B(PG8_SB(0, 1), cB + hstep); PG8_STAGE_A(PG8_SA(0, 0), gc, 0, 0); PG8_STAGE_A(PG8_SA(0, 1), gc, 1, 0);
    if (wr == 1) PG8_BAR;
    PG8_WAIT_V(2); PG8_BAR;
    PG8_STAGE_B(PG8_SB(1, 0), cB + kstep); PG8_STAGE_A(PG8_SA(1, 0), gc, 0, kstep); PG8_STAGE_B(PG8_SB(1, 1), cB + hstep + kstep);
    PG8_WAIT_V(6); PG8_BAR;
    for (;;) {
        const bool has_next = S.next(ui + 1, nxt);
        if (has_next) { PG8_CALC_G(nxt, gn); }
        else {
#pragma unroll
            for (int h = 0; h < 2; ++h)
#pragma unroll
                for (int i = 0; i < 2; ++i) gn[h][i] = gc[h][i];
        }
        const char* nB = has_next ? (const char*)g.Bt + (size_t)nxt.pn * tstep + (Sched::SPLIT ? (size_t)nxt.k0 : (size_t)0) : cB;
        const int cnt = Sched::SPLIT ? cur.nt : nt;
        const int csw = SWAPV ? cur.sw : 0;
        if constexpr (SWAPV) {
            if (csw == 3) {
#define SWC_ 3
                PG8_KLOOP()
#undef SWC_
            } else if (csw == 2) {
#define SWC_ 2
                PG8_KLOOP()
#undef SWC_
            } else {
#define SWC_ 0
                PG8_KLOOP()
#undef SWC_
            }
        } else {
#define SWC_ 0
            PG8_KLOOP()
#undef SWC_
        }
        if constexpr (ALIGN_EPI) { if (wr == 0) PG8_BAR; }
        E(acc, cur, wr, wc, fr, fq);
        if (!has_next) break;
#pragma unroll
        for (int a = 0; a < 2; ++a)
#pragma unroll
            for (int b = 0; b < 2; ++b)
#pragma unroll
                for (int m = 0; m < 4; ++m)
#pragma unroll
                    for (int n = 0; n < 2; ++n) acc[a][b][m][n] = (f32x4){0.f, 0.f, 0.f, 0.f};
        cur = nxt; cB = nB; ++ui;
#pragma unroll
        for (int h = 0; h < 2; ++h)
#pragma unroll
            for (int i = 0; i < 2; ++i) gc[h][i] = gn[h][i];
        if constexpr (ALIGN_EPI) { if (wr == 1) PG8_BAR; }
    }
    PG8_WAIT_V(0);
    if constexpr (!ALIGN_EPI) { if (wr == 0) PG8_BAR; }
    PG8_BAR;
#undef PG8_SA
#undef PG8_SB
#undef PG8_STAGE_A
#undef PG8_STAGE_B
#undef PG8_CALC_G
#undef PG8_LDA
#undef PG8_LDB
#undef PG8_MMA
#undef PG8_KLOOP
#undef PG8_WAIT_V
#undef PG8_WAIT_L
#undef PG8_BAR
#undef PG8_SCHED
}

struct EpiProj {
    bf16* base; float* gates;
    __device__ __forceinline__ void operator()(const f32x4 (&acc)[2][2][4][2], const Unit& u, int wr, int wc, int fr, int fq) const {
#pragma unroll
        for (int ai = 0; ai < 2; ++ai)
#pragma unroll
            for (int m = 0; m < 4; ++m) {
                const int row = u.pm * BM + ai * HALF + wr * 64 + m * 16 + fr, b = row >> 13, s = row & 8191;
#pragma unroll
                for (int bj = 0; bj < 2; ++bj) {
                    if ((u.sw >> bj) & 1) {
                        if (m & 1) continue;
                        const int rowb = u.pm * BM + ai * HALF + wr * 64 + m * 16 + 4 * fq, b2 = rowb >> 13, s2 = rowb & 8191;
                        int frx = fr; asm volatile("" : "+v"(frx));
#pragma unroll
                        for (int n = 0; n < 2; ++n) {
                            const int c = u.pn * BM + bj * HALF + wc * 32 + 8 * (frx >> 2) + 4 * n + (frx & 3), d = c & 63;
                            const f32x4 e0 = acc[ai][bj][m][n], e1 = acc[ai][bj][m + 1][n];
                            if (c < 2048) { const int h = (c & 511) >> 6;
                                u32x4 w; w.x = cvt_pk_bf16(e0[0], e0[1]); w.y = cvt_pk_bf16(e0[2], e0[3]); w.z = cvt_pk_bf16(e1[0], e1[1]); w.w = cvt_pk_bf16(e1[2], e1[3]);
                                *(u32x4*)(base + (size_t)2 * 8388608u + (size_t)(b2 * 8 + h) * SEQ * 64 + voff(s2, d)) = w;
                            } else { const int idx = c - 2048, br = idx >> 8, gg = (idx >> 6) & 1; const size_t tb2 = (size_t)4 * 8388608u + (size_t)(((br * 2 + 1) * 2 + b2) * 2 + gg) * SEQ * 64;
                                if (br == 1) { u32x2 q; q.x = cvt4_fp8(e0[0], e0[1], e0[2], e0[3]); q.y = cvt4_fp8(e1[0], e1[1], e1[2], e1[3]); *(u32x2*)((unsigned char*)(base + tb2) + v8off(s2, d)) = q; }
                                else { u32x4 w; w.x = cvt_pk_bf16(e0[0], e0[1]); w.y = cvt_pk_bf16(e0[2], e0[3]); w.z = cvt_pk_bf16(e1[0], e1[1]); w.w = cvt_pk_bf16(e1[2], e1[3]);
                                    *(u32x4*)(base + tb2 + voff(s2, d)) = w; }
                            }
                        }
                        continue;
                    }
                    const int c = u.pn * BM + bj * HALF + wc * 32 + 8 * fq;
                    const f32x4 v0 = acc[ai][bj][m][0], v1 = acc[ai][bj][m][1];
                    if (c < 2816) {
                        size_t tb_; int mode_ = 0; const int d = c & 63;
                        if (c < 2048) { const int region = c >> 9, h = (c & 511) >> 6; tb_ = (size_t)region * 8388608u + (size_t)(b * 8 + h) * SEQ * 64; mode_ = region == 1 ? 1 : (region == 2 ? 2 : 0); }
                        else { const int idx = c - 2048, br = idx >> 8, kv = (idx >> 7) & 1, gg = (idx >> 6) & 1;
                            tb_ = (size_t)4 * 8388608u + (size_t)(((br * 2 + kv) * 2 + b) * 2 + gg) * SEQ * 64; mode_ = br == 0 ? 0 : (kv == 0 ? 1 : 2); if (br == 1) mode_ += 2; }
                        u32x4 w; w.x = cvt_pk_bf16(v0[0], v0[1]); w.y = cvt_pk_bf16(v0[2], v0[3]); w.z = cvt_pk_bf16(v1[0], v1[1]); w.w = cvt_pk_bf16(v1[2], v1[3]);
                        if (mode_ >= 3) {
                            unsigned char* bp = (unsigned char*)(base + tb_);
                            const unsigned f0 = cvt4_fp8(v0[0], v0[1], v0[2], v0[3]), f1 = cvt4_fp8(v1[0], v1[1], v1[2], v1[3]);
                            if (mode_ == 3) { u32x2 q; q.x = f0; q.y = f1; *(u32x2*)(bp + k8off(s, d)) = q; }
                            else { unsigned char* tp = bp + v8off(s, d);
                                tp[0] = (unsigned char)f0; tp[16] = (unsigned char)(f0 >> 8); tp[32] = (unsigned char)(f0 >> 16); tp[48] = (unsigned char)(f0 >> 24);
                                tp[64] = (unsigned char)f1; tp[80] = (unsigned char)(f1 >> 8); tp[96] = (unsigned char)(f1 >> 16); tp[112] = (unsigned char)(f1 >> 24); }
                        } else if (mode_ == 2) {
                            bf16* tp = base + tb_ + voff(s, d);
                            tp[0] = (bf16)(w.x & 0xffffu); tp[8] = (bf16)(w.x >> 16); tp[16] = (bf16)(w.y & 0xffffu); tp[24] = (bf16)(w.y >> 16);
                            tp[32] = (bf16)(w.z & 0xffffu); tp[40] = (bf16)(w.z >> 16); tp[48] = (bf16)(w.w & 0xffffu); tp[56] = (bf16)(w.w >> 16);
                        } else *(u32x4*)(base + tb_ + (mode_ == 1 ? koff(s, d) : (size_t)s * 64 + d)) = w;
                    } else if (c < IN_COLS) {
                        float* gp = gates + (size_t)row * 24 + (c - 2816);
                        f32x4 a, bb;
#define SIGM(x_) __builtin_amdgcn_rcpf(1.f + __builtin_amdgcn_exp2f((x_) * -1.4426950408889634f))
                        a.x = SIGM(v0.x); a.y = SIGM(v0.y); a.z = SIGM(v0.z); a.w = SIGM(v0.w);
                        bb.x = SIGM(v1.x); bb.y = SIGM(v1.y); bb.z = SIGM(v1.z); bb.w = SIGM(v1.w);
#undef SIGM
                        *(f32x4*)gp = a; *(f32x4*)(gp + 4) = bb;
                    }
                }
            }
    }
};
struct EpiOutBf16 {
    bf16* O; int ldc;
    __device__ __forceinline__ void operator()(const f32x4 (&acc)[2][2][4][2], const Unit& u, int wr, int wc, int fr, int fq) const {
#pragma unroll
        for (int ai = 0; ai < 2; ++ai)
#pragma unroll
            for (int m = 0; m < 4; ++m) {
                const int row = u.pm * BM + ai * HALF + wr * 64 + m * 16 + fr;
#pragma unroll
                for (int bj = 0; bj < 2; ++bj) {
                    bf16* p = O + (size_t)row * ldc + (u.pn % (ldc / BM)) * BM + bj * HALF + wc * 32 + 8 * fq;
                    const f32x4 v0 = acc[ai][bj][m][0], v1 = acc[ai][bj][m][1];
                    u32x4 w; w.x = cvt_pk_bf16(v0[0], v0[1]); w.y = cvt_pk_bf16(v0[2], v0[3]); w.z = cvt_pk_bf16(v1[0], v1[1]); w.w = cvt_pk_bf16(v1[2], v1[3]);
                    *(u32x4*)p = w;
                }
            }
    }
};
struct EpiMoeDown {
    bf16* O; bf16* P; int row0;
    __device__ __forceinline__ void operator()(const f32x4 (&acc)[2][2][4][2], const Unit& u, int wr, int wc, int fr, int fq) const {
        bf16* Ob = u.part < 0 ? O : P + ((ptrdiff_t)u.part * 2048 - row0) * 1024;
#pragma unroll
        for (int ai = 0; ai < 2; ++ai)
#pragma unroll
            for (int m = 0; m < 4; ++m) {
                const int row = u.pm * BM + ai * HALF + wr * 64 + m * 16 + fr;
#pragma unroll
                for (int bj = 0; bj < 2; ++bj) {
                    bf16* p = Ob + (ptrdiff_t)row * 1024 + (u.pn & 3) * BM + bj * HALF + wc * 32 + 8 * fq;
                    const f32x4 v0 = acc[ai][bj][m][0], v1 = acc[ai][bj][m][1];
                    u32x4 w; w.x = cvt_pk_bf16(v0[0], v0[1]); w.y = cvt_pk_bf16(v0[2], v0[3]); w.z = cvt_pk_bf16(v1[0], v1[1]); w.w = cvt_pk_bf16(v1[2], v1[3]);
                    *(u32x4*)p = w;
                }
            }
    }
};
struct EpiSwiglu {
    bf16* Hd; int ldh; int nNper;
    __device__ __forceinline__ void operator()(const f32x4 (&acc)[2][2][4][2], const Unit& u, int wr, int wc, int fr, int fq) const {
        const int pnl = u.pn % nNper;
#pragma unroll
        for (int ai = 0; ai < 2; ++ai)
#pragma unroll
            for (int m = 0; m < 4; ++m) {
                const int row = u.pm * BM + ai * HALF + wr * 64 + m * 16 + fr;
                float h[8];
#pragma unroll
                for (int n = 0; n < 2; ++n)
#pragma unroll
                    for (int j = 0; j < 4; ++j) { const float gt = acc[ai][0][m][n][j], up = acc[ai][1][m][n][j]; h[n * 4 + j] = gt * __builtin_amdgcn_rcpf(1.f + __builtin_amdgcn_exp2f(gt * -1.4426950408889634f)) * up; }
                u32x4 w; w.x = cvt_pk_bf16(h[0], h[1]); w.y = cvt_pk_bf16(h[2], h[3]); w.z = cvt_pk_bf16(h[4], h[5]); w.w = cvt_pk_bf16(h[6], h[7]);
                *(u32x4*)(Hd + (size_t)row * ldh + pnl * HALF + wc * 32 + 8 * fq) = w;
            }
    }
};

struct CmpOrder { static constexpr bool SPLIT = false; int G, c;
    __device__ bool next(int i, Unit& u) const { const int L = i * G + c; if (L >= 16) return false; u.pm = L; u.pn = L >> 3; u.ga = 0; u.gl = 0; return true; } };
__device__ __forceinline__ float gelu_tanh_pg(float x) { const float uu = 0.7978845608028654f * (x + 0.044715f * x * x * x); const float t = 1.f - 2.f / (__expf(2.f * uu) + 1.f); return 0.5f * x * (1.f + t); }
struct EpiCmpHid {
    bf16* Hd; const float* bias;
    __device__ __forceinline__ void operator()(const f32x4 (&acc)[2][2][4][2], const Unit& u, int wr, int wc, int fr, int fq) const {
        const float* bp = bias + u.pn * 256;
#pragma unroll
        for (int ai = 0; ai < 2; ++ai)
#pragma unroll
            for (int m = 0; m < 4; ++m) {
                const int row = u.pm * BM + ai * HALF + wr * 64 + m * 16 + fr;
#pragma unroll
                for (int bj = 0; bj < 2; ++bj) {
                    const int col = bj * HALF + wc * 32 + 8 * fq;
                    const f32x4 b0 = *(const f32x4*)(bp + col), b1 = *(const f32x4*)(bp + col + 4);
                    float h[8];
#pragma unroll
                    for (int j = 0; j < 4; ++j) { h[j] = gelu_tanh_pg(acc[ai][bj][m][0][j] + b0[j]); h[4 + j] = gelu_tanh_pg(acc[ai][bj][m][1][j] + b1[j]); }
                    u32x4 w; w.x = cvt_pk_bf16(h[0], h[1]); w.y = cvt_pk_bf16(h[2], h[3]); w.z = cvt_pk_bf16(h[4], h[5]); w.w = cvt_pk_bf16(h[6], h[7]);
                    *(u32x4*)(Hd + (size_t)row * 256 + col) = w;
                }
            }
    }
};
}

#define XB_TMO      128
#define XB_XCNT(j)  (256  + 64 * (j))
#define XB_XSUB(j)  (1280 + 64 * (j))
#define XB_XGEN(j)  (2304 + 64 * (j))
#define XB_TOP      3328
#define XB_TOPGEN   3392
#define XCD_BAR_WORDS 3456
#define XB_SPIN_CAP (1u << 18)
__device__ __forceinline__ unsigned xb_ld(unsigned* p)              { return __hip_atomic_load(p, __ATOMIC_RELAXED, __HIP_MEMORY_SCOPE_AGENT); }
__device__ __forceinline__ unsigned xb_add(unsigned* p, unsigned v) { return __hip_atomic_fetch_add(p, v, __ATOMIC_RELAXED, __HIP_MEMORY_SCOPE_AGENT); }
__device__ __forceinline__ unsigned xb_xcc_id() { return (unsigned)__builtin_amdgcn_s_getreg((3 << 11) | 20) & 0xFu; }
#define XB_SPIN(cond, bar) do { unsigned _sp = 0; while (cond) { __builtin_amdgcn_s_sleep(1); \
    if ((++_sp & 255u) == 0u) { if (xb_ld(&(bar)[XB_TMO])) break; if (_sp > XB_SPIN_CAP) { atomicAdd(&(bar)[XB_TMO], 1u); break; } } } } while (0)
struct XcdBarrier { unsigned* bar; unsigned x; volatile LAS unsigned* st; };
__device__ __forceinline__ XcdBarrier xcd_barrier_post(unsigned* bar, volatile LAS unsigned* st) {
    XcdBarrier b; b.bar = bar; b.x = xb_xcc_id(); b.st = st;
    if (threadIdx.x == 0) (void)xb_add(&bar[XB_XCNT(b.x)], 1u);
    return b;
}
__device__ __forceinline__ void xcd_barrier_complete(unsigned* bar, unsigned x, unsigned& nloc, unsigned& nx) {
    const unsigned G = gridDim.x * gridDim.y * gridDim.z;
    unsigned sum, cnt, mine, sp = 0u;
    for (;;) {
        sum = 0u; cnt = 0u; mine = 0u;
#pragma unroll
        for (unsigned j = 0; j < 16; ++j) { const unsigned c = xb_ld(&bar[XB_XCNT(j)]); sum += c; cnt += (c > 0u) ? 1u : 0u; mine = (j == x) ? c : mine; }
        if (sum == G) break;
        __builtin_amdgcn_s_sleep(1);
        if ((++sp & 255u) == 0u) { if (xb_ld(&bar[XB_TMO])) break; if (sp > XB_SPIN_CAP) { atomicAdd(&bar[XB_TMO], 1u); break; } }
    }
    nloc = mine > 0u ? mine : 1u; nx = cnt > 0u ? cnt : 1u;
}
__device__ __forceinline__ void xcd_barrier(const XcdBarrier& b) {
    asm volatile("s_waitcnt vmcnt(0)" ::: "memory");
    __syncthreads();
    if (threadIdx.x == 0) {
        unsigned* bar = b.bar;
        __builtin_amdgcn_s_waitcnt(0);
        unsigned nloc = b.st[0], nx = b.st[1];
        if (nloc == 0u) { xcd_barrier_complete(bar, b.x, nloc, nx); b.st[0] = nloc; b.st[1] = nx; }
        const unsigned old = xb_add(&bar[XB_XSUB(b.x)], 1u);
        const unsigned gen = old / nloc;
        if (old + 1u == (gen + 1u) * nloc) {
            __builtin_amdgcn_fence(__ATOMIC_RELEASE, "agent");
            asm volatile("s_waitcnt vmcnt(0)" ::: "memory");
            const unsigned og = xb_add(&bar[XB_TOP], 1u);
            const unsigned tg = og / nx;
            if (og + 1u == (tg + 1u) * nx) xb_add(&bar[XB_TOPGEN], 1u);
            else XB_SPIN(xb_ld(&bar[XB_TOPGEN]) == tg, bar);
            __builtin_amdgcn_fence(__ATOMIC_ACQUIRE, "agent");
            xb_add(&bar[XB_XGEN(b.x)], 1u);
            asm volatile("s_waitcnt vmcnt(0)" ::: "memory");
        } else {
            XB_SPIN(xb_ld(&bar[XB_XGEN(b.x)]) == gen, bar);
            __builtin_amdgcn_fence(__ATOMIC_ACQUIRE, "agent");
            asm volatile("s_waitcnt vmcnt(0)" ::: "memory");
        }
    }
    __syncthreads();
}

struct Frame {
    LAS unsigned char* lds;
    int tid, lane, wave, vcu, G;
    const Args* a;
    unsigned char* ws;
};
#define LDS_WAIT() asm volatile("s_waitcnt lgkmcnt(0)" ::: "memory")

struct TItem { const float* W; bf16* WT; int K, N, mode, r; };
__device__ __forceinline__ void transpose_load(const TItem& t, int lane, float (&tv)[32]) {
    const int nblk = (t.N + 31) / 32, kb = t.r / nblk, nb = t.r % nblk, k0 = 64 * kb, n0 = 32 * nb;
    int nn = n0 + (lane & 31); nn = nn < t.N ? nn : t.N - 1;
    const float* wp = t.W + (size_t)(k0 + (lane >> 5)) * t.N + nn;
#pragma unroll
    for (int i = 0; i < 32; ++i) tv[i] = wp[(size_t)(2 * i) * t.N];
}
__device__ __forceinline__ void transpose_store(const TItem& t, int lane, LAS float* scr, const float (&tv)[32]) {
    const int nblk = (t.N + 31) / 32, kb = t.r / nblk, nb = t.r % nblk, k0 = 64 * kb, n0 = 32 * nb;
    const bool okn = n0 + (lane & 31) < t.N;
#pragma unroll
    for (int i = 0; i < 32; ++i) { const int kk = 2 * i + (lane >> 5); scr[kk * 33 + (lane & 31)] = okn ? tv[i] : 0.f; }
    LDS_WAIT(); asm volatile("" ::: "memory");
    const int c = lane & 7;
    const int drow0 = (t.mode == 0 ? n0 : ((n0 >> 7) * 256 + (n0 & 127) + (t.mode == 2 ? 128 : 0)));
#pragma unroll
    for (int j = 0; j < 4; ++j) { const int n = (lane >> 3) + 8 * j; const LAS float* s = scr + (8 * c) * 33 + n;
        u32x4 o; o.x = cvt_pk_bf16(s[0 * 33], s[1 * 33]); o.y = cvt_pk_bf16(s[2 * 33], s[3 * 33]); o.z = cvt_pk_bf16(s[4 * 33], s[5 * 33]); o.w = cvt_pk_bf16(s[6 * 33], s[7 * 33]);
        *(u32x4*)(t.WT + (size_t)(drow0 + n) * t.K + k0 + 8 * c) = o; }
    LDS_WAIT(); asm volatile("" ::: "memory");
}
template <bool SILU, int NVEC>
__device__ __forceinline__ void block_gemv(Frame& F, const float* a0, const float* a1, int K, const float* W, int N, int col0, const float* bias, float* out0, float* out1) {
    const int col = col0 + F.lane, kper = K / NWAVES, kbeg = F.wave * kper;
    float s0 = 0.f, s1 = 0.f;
#pragma unroll 32
    for (int k = kbeg; k < kbeg + kper; ++k) {
        const float w = W[(size_t)k * N + col];
        float x0 = a0[k]; if (SILU) x0 = x0 / (1.f + __expf(-x0));
        s0 += x0 * w;
        if (NVEC == 2) { float x1 = a1[k]; if (SILU) x1 = x1 / (1.f + __expf(-x1)); s1 += x1 * w; }
    }
    LAS float* red = (LAS float*)(F.lds + RING_OFF);
    red[(F.wave * 2 + 0) * 64 + F.lane] = s0; red[(F.wave * 2 + 1) * 64 + F.lane] = s1;
    __syncthreads();
    if (F.wave == 0) {
        float t0 = 0.f, t1 = 0.f;
#pragma unroll
        for (int w = 0; w < NWAVES; ++w) { t0 += red[(w * 2 + 0) * 64 + F.lane]; t1 += red[(w * 2 + 1) * 64 + F.lane]; }
        const float bv = bias ? bias[col] : 0.f;
        out0[col] = t0 + bv; if (NVEC == 2) out1[col] = t1 + bv;
    }
    __syncthreads();
}
__device__ __forceinline__ void phase_prologue(Frame& F) {
    const Args& A = *F.a; unsigned char* ws = F.ws;
    for (int it = F.vcu; it < 208; it += F.G) {
        if (it < 192) { const int l = it / 96, cc = it % 96;
            float* mod = (float*)(ws + WS_MOD) + (size_t)l * 2 * 6144;
            block_gemv<true, 2>(F, A.in[1], A.in[1] + DM, DM, A.in[3] + (size_t)l * DM * 6144, 6144, cc * 64, A.in[4] + (size_t)l * 6144, mod, mod + 6144);
        } else { const int r = it - 192, lk = r / 4, cc = r % 4, l = lk >> 1, kv = lk & 1;
            const float* pos = A.in[kv ? 16 : 13] + (size_t)l * 2048; const float* w1 = A.in[kv ? 17 : 14] + (size_t)l * 2048 * 256;
            float* cb = (float*)(ws + WS_CBIAS) + (size_t)(l * 2 + kv) * 256;
            block_gemv<false, 1>(F, pos, pos, 2048, w1, 256, cc * 64, nullptr, cb, cb);
        }
    }
    LAS float* scr = (LAS float*)(F.lds + RING_OFF + F.wave * 16384);
    const int gw = F.vcu * NWAVES + F.wave, NGW = F.G * NWAVES;
    constexpr int PER_L = 1424 + 512 + 256 + 256 + 8 + 8, N_L = 2 * PER_L, N_F = 3 * 1408, PER_E = 3 * 1792, N_ALL = N_L + N_F + NE * PER_E;
    auto decode = [&](int it, TItem& t) {
        int r = it; const float* W; int K, N, mode = 0; bf16* WT;
        if (r < N_L) { const int l = r / PER_L; r %= PER_L;
            if (r < 1424) { W = A.in[9] + (size_t)l * DM * IN_COLS; K = DM; N = IN_COLS; WT = (bf16*)(ws + WS_WIN) + (size_t)l * NPROJ * DM; }
            else if (r < 1936) { r -= 1424; W = A.in[10] + (size_t)l * DM * DM; K = DM; N = DM; WT = (bf16*)(ws + WS_WOUT) + (size_t)l * DM * DM; }
            else if (r < 2192) { r -= 1936; W = A.in[14] + (size_t)l * 2048 * 256; K = 2048; N = 256; WT = (bf16*)(ws + WS_CW1) + (size_t)(l * 2 + 0) * 256 * 2048; }
            else if (r < 2448) { r -= 2192; W = A.in[17] + (size_t)l * 2048 * 256; K = 2048; N = 256; WT = (bf16*)(ws + WS_CW1) + (size_t)(l * 2 + 1) * 256 * 2048; }
            else if (r < 2456) { r -= 2448; W = A.in[15] + (size_t)l * 256 * 64; K = 256; N = 64; WT = (bf16*)(ws + WS_CW2) + (size_t)(l * 2 + 0) * 64 * 256; }
            else { r -= 2456; W = A.in[18] + (size_t)l * 256 * 64; K = 256; N = 64; WT = (bf16*)(ws + WS_CW2) + (size_t)(l * 2 + 1) * 64 * 256; }
        } else if (r < N_L + N_F) { r -= N_L; const int which = r / 1408; r %= 1408;
            if (which == 0) { W = A.in[19]; K = DM; N = DFF; WT = (bf16*)(ws + WS_FGU); mode = 1; }
            else if (which == 1) { W = A.in[20]; K = DM; N = DFF; WT = (bf16*)(ws + WS_FGU); mode = 2; }
            else { W = A.in[21]; K = DFF; N = DM; WT = (bf16*)(ws + WS_FD); }
        } else { r -= N_L + N_F; const int e = r / PER_E; r %= PER_E; const int which = r / 1792; r %= 1792;
            if (which == 0) { W = A.in[24] + (size_t)e * DM * DFE; K = DM; N = DFE; WT = (bf16*)(ws + WS_MGU) + (size_t)e * 7168 * DM; mode = 1; }
            else if (which == 1) { W = A.in[25] + (size_t)e * DM * DFE; K = DM; N = DFE; WT = (bf16*)(ws + WS_MGU) + (size_t)e * 7168 * DM; mode = 2; }
            else { W = A.in[26] + (size_t)e * DFE * DM; K = DFE; N = DM; WT = (bf16*)(ws + WS_MD) + (size_t)e * DM * DFE; }
        }
        t.W = W; t.WT = WT; t.K = K; t.N = N; t.mode = mode; t.r = r;
    };
    int it = gw; TItem ia, ib; float ta[32], tb[32];
    if (it < N_ALL) {
        decode(it, ia); transpose_load(ia, F.lane, ta);
        for (;;) {
            const int n1 = it + NGW; const bool h1 = n1 < N_ALL;
            decode(h1 ? n1 : it, ib); transpose_load(ib, F.lane, tb);
            transpose_store(ia, F.lane, scr, ta);
            if (!h1) break;
            const int n2 = n1 + NGW; const bool h2 = n2 < N_ALL;
            decode(h2 ? n2 : n1, ia); transpose_load(ia, F.lane, ta);
            transpose_store(ib, F.lane, scr, tb);
            if (!h2) break;
            it = n2;
        }
    }
}

__device__ __forceinline__ void ld_row(const float* p, int lane, f32x4 (&v)[4]) {
#pragma unroll
    for (int i = 0; i < 4; ++i) v[i] = ((const f32x4*)p)[lane + 64 * i];
}
__device__ __forceinline__ void ld_row_bf16(const bf16* p, int lane, f32x4 (&v)[4]) {
#pragma unroll
    for (int i = 0; i < 4; ++i) { const u32x2 w = ((const u32x2*)p)[lane + 64 * i]; v[i] = (f32x4){__uint_as_float(w.x << 16), __uint_as_float(w.x & 0xffff0000u), __uint_as_float(w.y << 16), __uint_as_float(w.y & 0xffff0000u)}; }
}
__device__ __forceinline__ float sumsq(const f32x4 (&v)[4]) {
    float s = 0.f;
#pragma unroll
    for (int i = 0; i < 4; ++i) s += (v[i].x * v[i].x + v[i].y * v[i].y) + (v[i].z * v[i].z + v[i].w * v[i].w);
    return s;
}
__device__ __forceinline__ void st_row_bf16(bf16* p, int lane, const f32x4 (&v)[4]) {
#pragma unroll
    for (int i = 0; i < 4; ++i) { u32x2 w; w.x = cvt_pk_bf16(v[i].x, v[i].y); w.y = cvt_pk_bf16(v[i].z, v[i].w); ((u32x2*)p)[lane + 64 * i] = w; }
}
__device__ __forceinline__ void modulate(const f32x4 (&x)[4], float r, const float* g, const float* scale, const float* shift, int lane, f32x4 (&h)[4]) {
    f32x4 gv[4], sc[4], sh[4]; ld_row(g, lane, gv); ld_row(scale, lane, sc); ld_row(shift, lane, sh);
#pragma unroll
    for (int i = 0; i < 4; ++i) h[i] = x[i] * r * gv[i] * (1.f + sc[i]) + sh[i];
}
__device__ __forceinline__ void phase_h0(Frame& F) {
    const Args& A = *F.a; const float* mod = (const float*)(F.ws + WS_MOD);
    bf16* H = (bf16*)(F.ws + WS_H);
    for (int row = F.vcu * NWAVES + F.wave; row < T; row += F.G * NWAVES) {
        const int b = row >> 13; const float* mb = mod + (size_t)(0 * 2 + b) * 6144;
        f32x4 x[4], h[4]; ld_row(A.in[0] + (size_t)row * DM, F.lane, x);
        const float r = 1.f / sqrtf(wave_sum(sumsq(x)) * (1.f / DM) + EPS);
        modulate(x, r, A.in[5], mb + 1024, mb, F.lane, h);
        st_row_bf16(H + (size_t)row * DM, F.lane, h);
    }
}
__device__ __forceinline__ void phase_merge(Frame& F, int layer) {
    const Args& A = *F.a; const float* oraw = (const float*)(F.ws + AR_ORAW); bf16* H = (bf16*)(F.ws + WS_H);
    const float* gsb = A.in[11] + layer * 512; const float* gns = A.in[12] + layer * 512;
    for (int row = F.vcu * NWAVES + F.wave; row < T; row += F.G * NWAVES) {
        f32x4 v[4]; ld_row(oraw + (size_t)row * DM, F.lane, v);
        float s0 = (v[0].x * v[0].x + v[0].y * v[0].y) + (v[0].z * v[0].z + v[0].w * v[0].w) + (v[1].x * v[1].x + v[1].y * v[1].y) + (v[1].z * v[1].z + v[1].w * v[1].w);
        float s1 = (v[2].x * v[2].x + v[2].y * v[2].y) + (v[2].z * v[2].z + v[2].w * v[2].w) + (v[3].x * v[3].x + v[3].y * v[3].y) + (v[3].z * v[3].z + v[3].w * v[3].w);
        const float r0 = 1.f / sqrtf(wave_sum(s0) * (1.f / 512) + EPS), r1 = 1.f / sqrtf(wave_sum(s1) * (1.f / 512) + EPS);
        f32x4 o[4];
#pragma unroll
        for (int i = 0; i < 2; ++i) { o[i] = v[i] * r0 * ((const f32x4*)gsb)[F.lane + 64 * i]; o[2 + i] = v[2 + i] * r1 * ((const f32x4*)gns)[F.lane + 64 * i]; }
        st_row_bf16(H + (size_t)row * DM, F.lane, o);
    }
}
__device__ __forceinline__ void phase_post_mix(Frame& F, int layer) {
    const Args& A = *F.a; const float* mod = (const float*)(F.ws + WS_MOD);
    const bf16* mbuf = (const bf16*)(F.ws + AR_M); bf16* H = (bf16*)(F.ws + WS_H);
    const float* xin = layer == 0 ? A.in[0] : A.out;
    unsigned* cnt = (unsigned*)(F.ws + WS_CTL) + CW_CNT; unsigned* tokinfo = (unsigned*)(F.ws + AR_TOKINFO);
    for (int row = F.vcu * NWAVES + F.wave; row < T; row += F.G * NWAVES) {
        const int b = row >> 13; const float* mb = mod + (size_t)(layer * 2 + b) * 6144;
        f32x4 x[4], m[4], g[4], gt[4], h[4];
        ld_row(xin + (size_t)row * DM, F.lane, x); ld_row_bf16(mbuf + (size_t)row * DM, F.lane, m);
        ld_row(A.in[6] + layer * DM, F.lane, g); ld_row(mb + 2048, F.lane, gt);
        const float r = 1.f / sqrtf(wave_sum(sumsq(m)) * (1.f / DM) + EPS);
#pragma unroll
        for (int i = 0; i < 4; ++i) { x[i] = x[i] + gt[i] * (m[i] * r * g[i]); ((f32x4*)(A.out + (size_t)row * DM))[F.lane + 64 * i] = x[i]; }
        const float r2 = 1.f / sqrtf(wave_sum(sumsq(x)) * (1.f / DM) + EPS);
        modulate(x, r2, A.in[7] + layer * DM, mb + 4096, mb + 3072, F.lane, h);
        st_row_bf16(H + (size_t)row * DM, F.lane, h);
        if (layer == 1) {
            const float* wr = A.in[22]; float lg[8];
#pragma unroll
            for (int e = 0; e < 8; ++e) lg[e] = 0.f;
#pragma unroll
            for (int i = 0; i < 4; ++i)
#pragma unroll
                for (int j = 0; j < 4; ++j) { const int k = i * 256 + F.lane * 4 + j; const f32x4 w0 = *(const f32x4*)(wr + k * 8), w1 = *(const f32x4*)(wr + k * 8 + 4); const float hv = h[i][j];
                    lg[0] += hv * w0.x; lg[1] += hv * w0.y; lg[2] += hv * w0.z; lg[3] += hv * w0.w; lg[4] += hv * w1.x; lg[5] += hv * w1.y; lg[6] += hv * w1.z; lg[7] += hv * w1.w; }
            float mx = -3.0e38f;
#pragma unroll
            for (int e = 0; e < 8; ++e) { lg[e] = wave_sum(lg[e]) + A.in[23][e]; mx = fmaxf(mx, lg[e]); }
            float p[8], sum = 0.f;
#pragma unroll
            for (int e = 0; e < 8; ++e) { p[e] = __expf(lg[e] - mx); sum += p[e]; }
            const float inv = 1.f / sum;
#pragma unroll
            for (int e = 0; e < 8; ++e) p[e] *= inv;
            int e0 = 0; float p0 = p[0];
#pragma unroll
            for (int e = 1; e < 8; ++e) if (p[e] > p0) { p0 = p[e]; e0 = e; }
            int e1 = -1; float p1 = -1.f;
#pragma unroll
            for (int e = 0; e < 8; ++e) if (e != e0 && p[e] > p1) { p1 = p[e]; e1 = e; }
            const float ws2 = p0 + p1;
            if (F.lane == 0) {
                const unsigned pos0 = atomicAdd(&cnt[e0], 1u), pos1 = atomicAdd(&cnt[e1], 1u);
                u32x4 a0, a1; a0.x = (unsigned)e0; a0.y = (unsigned)e1; a0.z = pos0; a0.w = pos1;
                a1.x = __float_as_uint(p0 / ws2); a1.y = __float_as_uint(p1 / ws2); a1.z = 0u; a1.w = 0u;
                *(u32x4*)(tokinfo + (size_t)row * 8) = a0; *(u32x4*)(tokinfo + (size_t)row * 8 + 4) = a1;
                int* rowtok = (int*)(F.ws + AR_ROWTOK);
                rowtok[e0 * 16384 + (int)pos0] = row; rowtok[e1 * 16384 + (int)pos1] = row;
            }
        }
    }
}
constexpr int MOETBL_OFF = LDSCTL_OFF + 1280;
__device__ __forceinline__ void moe_table_build(Frame& F) {
    LAS int* tbl = (LAS int*)(F.lds + MOETBL_OFF);
    if (F.tid == 0) {
        unsigned* cnt = (unsigned*)(F.ws + WS_CTL) + CW_CNT; int acc = 0;
        for (int e = 0; e < 8; ++e) { const int c = (int)__hip_atomic_load(&cnt[e], __ATOMIC_RELAXED, __HIP_MEMORY_SCOPE_AGENT); tbl[e] = acc; tbl[8 + e] = c; tbl[16 + e] = (c + 255) >> 8; acc += (c + 255) >> 8; }
        int nfull = acc, S = 1;
        if ((F.G & 3) == 0) { const int nf = (acc * 4 / F.G) * (F.G / 4), ntail = acc - nf; if (ntail > 0 && ntail <= 8 && ntail * 28 <= F.G) { nfull = nf; S = 7; } }
        tbl[24] = nfull; tbl[25] = S;
    }
    __syncthreads();
}
__device__ __forceinline__ void moe_y_row(Frame& F, int r, int tail0, int nS, f32x4 (&y)[4]) {
    if (r < tail0 || nS <= 1) { ld_row_bf16((const bf16*)(F.ws + WS_Y) + (size_t)r * DM, F.lane, y); return; }
    const bf16* pp = (const bf16*)(F.ws + WS_YPART) + (size_t)(r - tail0) * DM;
    ld_row_bf16(pp, F.lane, y);
    for (int s = 1; s < nS; ++s) { f32x4 t[4]; ld_row_bf16(pp + (size_t)s * 2048 * DM, F.lane, t);
#pragma unroll
        for (int i = 0; i < 4; ++i) y[i] = y[i] + t[i]; }
}
__device__ __forceinline__ void phase_post_ffn(Frame& F, int layer) {
    const Args& A = *F.a; const float* mod = (const float*)(F.ws + WS_MOD); bf16* H = (bf16*)(F.ws + WS_H);
    if (layer == 1) moe_table_build(F);
    const LAS int* tbl = (const LAS int*)(F.lds + MOETBL_OFF);
    const unsigned* tokinfo = (const unsigned*)(F.ws + AR_TOKINFO);
    for (int row = F.vcu * NWAVES + F.wave; row < T; row += F.G * NWAVES) {
        const int b = row >> 13; const float* mb = mod + (size_t)(layer * 2 + b) * 6144;
        f32x4 x[4], f[4], g[4], gt[4];
        ld_row(A.out + (size_t)row * DM, F.lane, x);
        if (layer == 0) ld_row_bf16((const bf16*)(F.ws + AR_FOUT) + (size_t)row * DM, F.lane, f);
        else {
            const u32x4 a0 = *(const u32x4*)(tokinfo + (size_t)row * 8), a1 = *(const u32x4*)(tokinfo + (size_t)row * 8 + 4);
            const int r0 = tbl[a0.x] * 256 + (int)a0.z, r1 = tbl[a0.y] * 256 + (int)a0.w;
            const float w0 = __uint_as_float(a1.x), w1 = __uint_as_float(a1.y);
            f32x4 y0[4], y1[4]; const int tail0 = tbl[24] * 256, nS = tbl[25];
            moe_y_row(F, r0, tail0, nS, y0); moe_y_row(F, r1, tail0, nS, y1);
#pragma unroll
            for (int i = 0; i < 4; ++i) f[i] = y0[i] * w0 + y1[i] * w1;
        }
        ld_row(A.in[8] + layer * DM, F.lane, g); ld_row(mb + 5120, F.lane, gt);
        const float r = 1.f / sqrtf(wave_sum(sumsq(f)) * (1.f / DM) + EPS);
#pragma unroll
        for (int i = 0; i < 4; ++i) { x[i] = x[i] + gt[i] * (f[i] * r * g[i]); ((f32x4*)(A.out + (size_t)row * DM))[F.lane + 64 * i] = x[i]; }
        if (layer == 0) {
            const float* mb1 = mod + (size_t)(1 * 2 + b) * 6144; f32x4 h[4];
            const float r2 = 1.f / sqrtf(wave_sum(sumsq(x)) * (1.f / DM) + EPS);
            modulate(x, r2, A.in[5] + DM, mb1 + 1024, mb1, F.lane, h);
            st_row_bf16(H + (size_t)row * DM, F.lane, h);
        }
    }
}

__device__ __forceinline__ float gelu_tanh(float x) { const float u = 0.7978845608028654f * (x + 0.044715f * x * x * x); const float t = 1.f - 2.f / (__expf(2.f * u) + 1.f); return 0.5f * x * (1.f + t); }
__device__ __forceinline__ void cmp_out_unit(Frame& F, int layer, int pm) {
    const int t = pm >> 1, kv = t >> 2, bg = t & 3, rbase = (pm & 1) * 256;
    const bf16* hid = (const bf16*)(F.ws + AR_CHID) + (size_t)pm * 256 * 256;
    const bf16* w2t = (const bf16*)(F.ws + WS_CW2) + (size_t)(layer * 2 + kv) * 64 * 256;
    bf16* outp = (bf16*)(F.ws + AR_KC) + (size_t)(kv * 4 + bg) * 512 * 64;
    const int w = F.wave, fr = F.lane & 15, fq = F.lane >> 4;
    f32x4 acc[2][4];
#pragma unroll
    for (int m = 0; m < 2; ++m)
#pragma unroll
        for (int n = 0; n < 4; ++n) acc[m][n] = (f32x4){0.f, 0.f, 0.f, 0.f};
#pragma unroll
    for (int kk = 0; kk < 8; ++kk) {
        bf16x8 a[2], b[4];
#pragma unroll
        for (int m = 0; m < 2; ++m) a[m] = *(const bf16x8*)(hid + (size_t)(w * 32 + m * 16 + fr) * 256 + kk * 32 + fq * 8);
#pragma unroll
        for (int n = 0; n < 4; ++n) b[n] = *(const bf16x8*)(w2t + (size_t)(n * 16 + fr) * 256 + kk * 32 + fq * 8);
#pragma unroll
        for (int m = 0; m < 2; ++m)
#pragma unroll
            for (int n = 0; n < 4; ++n) acc[m][n] = __builtin_amdgcn_mfma_f32_16x16x32_bf16(a[m], b[n], acc[m][n], 0, 0, 0);
    }
#pragma unroll
    for (int m = 0; m < 2; ++m)
#pragma unroll
        for (int n = 0; n < 4; ++n)
#pragma unroll
            for (int r = 0; r < 4; ++r) { const int row = rbase + w * 32 + m * 16 + fq * 4 + r, col = n * 16 + fr;
                const bf16 ov = row < NCMP ? (bf16)(cvt_pk_bf16(acc[m][n][r], 0.f) & 0xffffu) : (bf16)0;
                outp[kv == 0 ? koff(row, col) : voff(row, col)] = ov; }
}

struct KF { bf16x8 lo, hi; };
__device__ __forceinline__ int lane_off(int lane) { return (lane >> 4) * 128 + (lane & 15) * 8; }
__device__ __forceinline__ KF ld_kf(const bf16* row, int fq) { KF k; k.lo = *(const bf16x8*)(row + 8 * fq); k.hi = *(const bf16x8*)(row + 32 + 8 * fq); return k; }
__device__ __forceinline__ KF ld_kt(const bf16* Kt, int k0, int lane) { KF k; const bf16* p = Kt + (size_t)(k0 >> 4) * 1024 + lane_off(lane); k.lo = *(const bf16x8*)p; k.hi = *(const bf16x8*)(p + 512); return k; }
__device__ __forceinline__ bf16x8 ld_vt(const bf16* Vt, int k0, int dt, int lane) { return *(const bf16x8*)(Vt + (size_t)(k0 >> 5) * 2048 + dt * 512 + lane_off(lane)); }
__device__ __forceinline__ f32x4 qk16(const KF& k, const KF& q) { f32x4 z = {0.f, 0.f, 0.f, 0.f}; z = __builtin_amdgcn_mfma_f32_16x16x32_bf16(k.lo, q.lo, z, 0, 0, 0); z = __builtin_amdgcn_mfma_f32_16x16x32_bf16(k.hi, q.hi, z, 0, 0, 0); return z; }
__device__ __forceinline__ bf16x8 pack_p(const f32x4& p0, const f32x4& p1) { const u32x4 w = {cvt_pk_bf16(p0[0], p0[1]), cvt_pk_bf16(p0[2], p0[3]), cvt_pk_bf16(p1[0], p1[1]), cvt_pk_bf16(p1[2], p1[3])}; return __builtin_bit_cast(bf16x8, w); }
__device__ __forceinline__ float fq_max(float v) {
    auto a = __builtin_amdgcn_permlane16_swap(__float_as_uint(v), __float_as_uint(v), false, false); v = fmaxf(__uint_as_float(a[0]), __uint_as_float(a[1]));
    auto b = __builtin_amdgcn_permlane32_swap(__float_as_uint(v), __float_as_uint(v), false, false); return fmaxf(__uint_as_float(b[0]), __uint_as_float(b[1])); }
__device__ __forceinline__ float fq_sum(float v) {
    auto a = __builtin_amdgcn_permlane16_swap(__float_as_uint(v), __float_as_uint(v), false, false); v = __uint_as_float(a[0]) + __uint_as_float(a[1]);
    auto b = __builtin_amdgcn_permlane32_swap(__float_as_uint(v), __float_as_uint(v), false, false); return __uint_as_float(b[0]) + __uint_as_float(b[1]); }
__device__ __forceinline__ float xor16f(float v) { auto a = __builtin_amdgcn_permlane16_swap(__float_as_uint(v), __float_as_uint(v), false, false); return __uint_as_float(((threadIdx.x >> 4) & 1) ? a[0] : a[1]); }
__device__ __forceinline__ float xor32f(float v) { auto a = __builtin_amdgcn_permlane32_swap(__float_as_uint(v), __float_as_uint(v), false, false); return __uint_as_float(((threadIdx.x >> 5) & 1) ? a[0] : a[1]); }
__device__ __forceinline__ float quad_x1(float v) { return __uint_as_float(__builtin_amdgcn_update_dpp(0, __float_as_uint(v), 0xB1, 0xf, 0xf, true)); }
__device__ __forceinline__ float quad_x2(float v) { return __uint_as_float(__builtin_amdgcn_update_dpp(0, __float_as_uint(v), 0x4E, 0xf, 0xf, true)); }
constexpr float QK_C = 0.125f * 1.4426950408889634f;
constexpr float NEG_INF = -__builtin_huge_valf();
__device__ __forceinline__ bf16x8 osm_step(f32x4& s0, f32x4& s1, float& m, float& l, f32x4 (&O)[4]) {
    float smax = fmaxf(fmaxf(fmaxf(s0[0], s0[1]), fmaxf(s0[2], s0[3])), fmaxf(fmaxf(s1[0], s1[1]), fmaxf(s1[2], s1[3])));
    smax = fq_max(smax);
    {
        const float mnew = fmaxf(m, smax), muse = (mnew == NEG_INF) ? 0.f : mnew;
        const float alpha = __builtin_amdgcn_exp2f(m - muse);
        l *= alpha; m = mnew;
#pragma unroll
        for (int dt = 0; dt < 4; ++dt) O[dt] = O[dt] * alpha;
    }
    const float muse = (m == NEG_INF) ? 0.f : m;
    float ps = 0.f;
#pragma unroll
    for (int r = 0; r < 4; ++r) { s0[r] = __builtin_amdgcn_exp2f(s0[r] - muse); s1[r] = __builtin_amdgcn_exp2f(s1[r] - muse); ps += s0[r] + s1[r]; }
    l += ps;
    return pack_p(s0, s1);
}

__device__ __forceinline__ void osm_step8x2(f32x4& a0, f32x4& a1, float& mA, float& lA, f32x4 (&OA)[4], f32x4& b0, f32x4& b1, float& mB, float& lB, f32x4 (&OB)[4], long& pa, long& pb) {
    float xa = fmaxf(fmaxf(fmaxf(a0[0], a0[1]), fmaxf(a0[2], a0[3])), fmaxf(fmaxf(a1[0], a1[1]), fmaxf(a1[2], a1[3])));
    float xb = fmaxf(fmaxf(fmaxf(b0[0], b0[1]), fmaxf(b0[2], b0[3])), fmaxf(fmaxf(b1[0], b1[1]), fmaxf(b1[2], b1[3])));
    xa = fq_max(xa); xb = fq_max(xb);
    const float nA = fmaxf(mA, xa), nB = fmaxf(mB, xb);
    if (__builtin_amdgcn_ballot_w64((nA > mA) || (nB > mB)) != 0ull) {
        const float ua = (nA == NEG_INF) ? 0.f : nA, ub = (nB == NEG_INF) ? 0.f : nB;
        const float fa = __builtin_amdgcn_exp2f(mA - ua), fb = __builtin_amdgcn_exp2f(mB - ub);
        lA *= fa; lB *= fb; mA = nA; mB = nB;
#pragma unroll
        for (int dt = 0; dt < 4; ++dt) { OA[dt] = OA[dt] * fa; OB[dt] = OB[dt] * fb; }
    }
    const float ua = ((mA == NEG_INF) ? 0.f : mA) - 6.f, ub = ((mB == NEG_INF) ? 0.f : mB) - 6.f;
    float sa = 0.f, sb = 0.f;
#pragma unroll
    for (int r = 0; r < 4; ++r) { a0[r] = __builtin_amdgcn_exp2f(a0[r] - ua); a1[r] = __builtin_amdgcn_exp2f(a1[r] - ua); sa += a0[r] + a1[r];
                                  b0[r] = __builtin_amdgcn_exp2f(b0[r] - ub); b1[r] = __builtin_amdgcn_exp2f(b1[r] - ub); sb += b0[r] + b1[r]; }
    lA += sa; lB += sb;
    const unsigned w0 = cvt4_fp8(a0[0], a0[1], a0[2], a0[3]), w1 = cvt4_fp8(a1[0], a1[1], a1[2], a1[3]);
    const unsigned v0 = cvt4_fp8(b0[0], b0[1], b0[2], b0[3]), v1 = cvt4_fp8(b1[0], b1[1], b1[2], b1[3]);
    pa = (long)(((unsigned long long)w1 << 32) | w0); pb = (long)(((unsigned long long)v1 << 32) | v0);
}

__device__ __forceinline__ void win_task(Frame& F, int task) {
    const int bg = task >> 9, t0 = (task & 511) * 16, b = bg >> 1, g = bg & 1, fr = F.lane & 15, fq = F.lane >> 4, t = t0 + fr;
    const bf16* Kp = (const bf16*)(F.ws + AR_NKV) + (size_t)((2 * 2 + 0) * 4 + bg) * SEQ * 64;
    const bf16* VT = (const bf16*)(F.ws + AR_NKV) + (size_t)((2 * 2 + 1) * 4 + bg) * SEQ * 64;
    const bf16* Q = (const bf16*)(F.ws + AR_NQ) + ((size_t)(b * 8 + g * 4) * SEQ + t) * 64;
    const LAS float* bl = (const LAS float*)(F.lds + BIASL_OFF) + (g * 4) * 132;
    KF qf[4]; f32x4 O[4][4]; float m[4], l[4];
#pragma unroll
    for (int z = 0; z < 4; ++z) { qf[z] = ld_kf(Q + (size_t)z * SEQ * 64, fq); m[z] = NEG_INF; l[z] = 0.f;
#pragma unroll
        for (int dt = 0; dt < 4; ++dt) O[z][dt] = (f32x4){0.f, 0.f, 0.f, 0.f}; }
    int kstart = t0 - 511; kstart = kstart < 0 ? 0 : (kstart & ~31);
    KF ka = ld_kt(Kp, kstart, F.lane), kb = ld_kt(Kp, kstart + 16, F.lane);
    bf16x8 vf[4];
#pragma unroll
    for (int dt = 0; dt < 4; ++dt) vf[dt] = ld_vt(VT, kstart, dt, F.lane);
#pragma clang loop unroll(disable)
    for (int k0 = kstart; k0 <= t0 + 15; k0 += 32) {
        const int kn = (k0 + 32 <= t0 + 15) ? k0 + 32 : k0;
        const KF nka = ld_kt(Kp, kn, F.lane), nkb = ld_kt(Kp, kn + 16, F.lane);
        bf16x8 nvf[4];
#pragma unroll
        for (int dt = 0; dt < 4; ++dt) nvf[dt] = ld_vt(VT, kn, dt, F.lane);
        const int d0 = t - (k0 + 4 * fq);
        const bool interior = (k0 + 31 + 128 <= t0) && (t0 + 15 - k0 < 512);
        f32x4 s0[4], s1[4]; bf16x8 pf[4];
#pragma unroll
        for (int z = 0; z < 4; ++z) { s0[z] = qk16(ka, qf[z]); s1[z] = qk16(kb, qf[z]); }
        if (interior) {
#pragma unroll
            for (int z = 0; z < 4; ++z) { const float bb = bl[z * 132 + 128];
#pragma unroll
                for (int r = 0; r < 4; ++r) { s0[z][r] = s0[z][r] * QK_C + bb; s1[z][r] = s1[z][r] * QK_C + bb; } }
        } else {
#pragma unroll
            for (int z = 0; z < 4; ++z)
#pragma unroll
                for (int r = 0; r < 4; ++r) {
                    const int da = d0 - r, db = d0 - 16 - r;
                    const int ia = da < 0 ? 0 : (da > 128 ? 128 : da), ib = db < 0 ? 0 : (db > 128 ? 128 : db);
                    s0[z][r] = ((unsigned)da < 512u) ? s0[z][r] * QK_C + bl[z * 132 + ia] : NEG_INF;
                    s1[z][r] = ((unsigned)db < 512u) ? s1[z][r] * QK_C + bl[z * 132 + ib] : NEG_INF;
                }
        }
#pragma unroll
        for (int z = 0; z < 4; ++z) pf[z] = osm_step(s0[z], s1[z], m[z], l[z], O[z]);
#pragma unroll
        for (int z = 0; z < 4; ++z)
#pragma unroll
            for (int dt = 0; dt < 4; ++dt) O[z][dt] = __builtin_amdgcn_mfma_f32_16x16x32_bf16(vf[dt], pf[z], O[z][dt], 0, 0, 0);
        ka = nka; kb = nkb;
#pragma unroll
        for (int dt = 0; dt < 4; ++dt) vf[dt] = nvf[dt];
    }
    const float* gt = (const float*)(F.ws + AR_GATES) + (size_t)(b * SEQ + t) * 24 + (g * 4) * 3 + 2;
    float* op = (float*)(F.ws + AR_OWIN) + (size_t)(b * SEQ + t) * 512 + (g * 4) * 64 + 4 * fq;
#pragma unroll
    for (int z = 0; z < 4; ++z) { const float sc = gt[z * 3] / fmaxf(fq_sum(l[z]), 1e-30f);
#pragma unroll
        for (int dt = 0; dt < 4; ++dt) *(f32x4*)(op + z * 64 + 16 * dt) = O[z][dt] * sc; }
}


__device__ __forceinline__ void sb_task(Frame& F, int task) {
    const int bh = task >> 9, t0 = (task & 511) * 16, fr = F.lane & 15, fq = F.lane >> 4, t = t0 + fr;
    const bf16* Kp = (const bf16*)(F.ws + AR_SBK) + (size_t)bh * SEQ * 64;
    const bf16* VT = (const bf16*)(F.ws + AR_SBV) + (size_t)bh * SEQ * 64;
    const KF qf = ld_kf((const bf16*)(F.ws + AR_SBQ) + ((size_t)bh * SEQ + t) * 64, fq);
    f32x4 O[4];
#pragma unroll
    for (int dt = 0; dt < 4; ++dt) O[dt] = (f32x4){0.f, 0.f, 0.f, 0.f};
    float carry = 0.f;
    const bool g1 = (fq ^ 1) > fq, g2 = (fq ^ 2) > fq, g3 = (fq ^ 3) > fq;
    const int kfirst = (t0 + 14) & ~31;
    KF ka = ld_kt(Kp, kfirst, F.lane), kb = ld_kt(Kp, kfirst + 16, F.lane);
    bf16x8 vf[4];
#pragma unroll
    for (int dt = 0; dt < 4; ++dt) vf[dt] = ld_vt(VT, kfirst, dt, F.lane);
#pragma clang loop unroll(disable)
    for (int k0 = kfirst; k0 >= 0; k0 -= 32) {
        const int kn = k0 >= 32 ? k0 - 32 : k0;
        const KF nka = ld_kt(Kp, kn, F.lane), nkb = ld_kt(Kp, kn + 16, F.lane);
        bf16x8 nvf[4];
#pragma unroll
        for (int dt = 0; dt < 4; ++dt) nvf[dt] = ld_vt(VT, kn, dt, F.lane);
        f32x4 z0 = qk16(ka, qf), z1 = qk16(kb, qf), L0, L1;
        const int key0 = k0 + 4 * fq;
#pragma unroll
        for (int r = 0; r < 4; ++r) {
            z0[r] *= QK_C; z1[r] *= QK_C;
            const float la = fmaxf(z0[r], 0.f) + __builtin_amdgcn_logf(1.f + __builtin_amdgcn_exp2f(-fabsf(z0[r])));
            const float lb = fmaxf(z1[r], 0.f) + __builtin_amdgcn_logf(1.f + __builtin_amdgcn_exp2f(-fabsf(z1[r])));
            L0[r] = (key0 + r < t) ? la : 0.f;
            L1[r] = (key0 + 16 + r < t) ? lb : 0.f;
        }
        f32x4 c0, c1;
        c1[3] = L1[3]; c1[2] = c1[3] + L1[2]; c1[1] = c1[2] + L1[1]; c1[0] = c1[1] + L1[0];
        c0[3] = L0[3]; c0[2] = c0[3] + L0[2]; c0[1] = c0[2] + L0[1]; c0[0] = c0[1] + L0[0];
        const float a1 = xor16f(c1[0]), a2 = xor32f(c1[0]), a3 = xor32f(a1);
        const float b1 = xor16f(c0[0]), b2 = xor32f(c0[0]), b3 = xor32f(b1);
        const float tot1 = c1[0] + a1 + a2 + a3, tot0 = c0[0] + b1 + b2 + b3;
        const float e1 = carry + (g1 ? a1 : 0.f) + (g2 ? a2 : 0.f) + (g3 ? a3 : 0.f);
        const float e0 = carry + tot1 + (g1 ? b1 : 0.f) + (g2 ? b2 : 0.f) + (g3 ? b3 : 0.f);
        f32x4 p0, p1;
#pragma unroll
        for (int r = 0; r < 4; ++r) {
            const float pa = __builtin_amdgcn_exp2f(z0[r] - (e0 + c0[r])), pb = __builtin_amdgcn_exp2f(z1[r] - (e1 + c1[r]));
            p0[r] = (key0 + r < t) ? pa : 0.f;
            p1[r] = (key0 + 16 + r < t) ? pb : 0.f;
        }
        carry += tot1 + tot0;
        const bf16x8 pf = pack_p(p0, p1);
#pragma unroll
        for (int dt = 0; dt < 4; ++dt) O[dt] = __builtin_amdgcn_mfma_f32_16x16x32_bf16(vf[dt], pf, O[dt], 0, 0, 0);
        if (__all(carry > 159.f)) break;
        ka = nka; kb = nkb;
#pragma unroll
        for (int dt = 0; dt < 4; ++dt) vf[dt] = nvf[dt];
    }
    float* op = (float*)(F.ws + AR_ORAW) + (size_t)((bh >> 3) * SEQ + t) * DM + (bh & 7) * 64 + 4 * fq;
#pragma unroll
    for (int dt = 0; dt < 4; ++dt) *(f32x4*)(op + 16 * dt) = O[dt];
}


__device__ __forceinline__ void nsa_task(Frame& F, int task) {
    const int bg = task >> 11, tq_ = task & 2047, tb = (2047 - tq_) * 4, b = bg >> 1,
                g = bg & 1, fr = F.lane & 15, fq = F.lane >> 4, tl = fr >> 2, z = fr & 3, t = tb + tl, hh = g * 4 + z;
    LAS float* imp = (LAS float*)(F.lds + RING_OFF + F.wave * 8192);
    LAS unsigned char* sel = (LAS unsigned char*)(F.lds + RING_OFF + F.wave * 8192 + 4224);
    const bf16* KC = (const bf16*)(F.ws + AR_KC) + (size_t)(0 * 4 + bg) * 512 * 64;
    const bf16* VCT = (const bf16*)(F.ws + AR_KC) + (size_t)(1 * 4 + bg) * 512 * 64;
    const bf16* KS = (const bf16*)(F.ws + AR_NKV) + (size_t)((1 * 2 + 0) * 4 + bg) * SEQ * 64;
    const bf16* VST = (const bf16*)(F.ws + AR_NKV) + (size_t)((1 * 2 + 1) * 4 + bg) * SEQ * 64;
    const bf16* Qg = (const bf16*)(F.ws + AR_NQ) + (size_t)(b * 8 + g * 4) * SEQ * 64;
    const float* gates = (const float*)(F.ws + AR_GATES);
    const LAS float* bl = (const LAS float*)(F.lds + BIASL_OFF) + hh * 132;
    for (int i = F.lane; i < 2 * 4 * 132; i += 64) imp[i] = 0.f;
    const KF qf = ld_kf(Qg + ((size_t)z * SEQ + t) * 64, fq);
    int nvis = t >= 31 ? ((t - 31) >> 4) + 1 : 0; nvis = nvis > NCMP ? NCMP : nvis;
    int nmax = (tb + 3) >= 31 ? ((tb + 3 - 31) >> 4) + 1 : 0; nmax = nmax > NCMP ? NCMP : nmax;
    const int dbase = t - 31 - 16 * (4 * fq);
    const float bfar = bl[128];
    float m = NEG_INF, l = 0.f;
    KF ka = ld_kt(KC, 0, F.lane), kb = ld_kt(KC, 16, F.lane);
#pragma clang loop unroll(disable)
    for (int n0 = 0; n0 < nmax; n0 += 32) {
        const int nn = n0 + 32 < nmax ? n0 + 32 : n0;
        const KF nka = ld_kt(KC, nn, F.lane), nkb = ld_kt(KC, nn + 16, F.lane);
        f32x4 s0 = qk16(ka, qf), s1 = qk16(kb, qf);
        ka = nka; kb = nkb;
        if (16 * (n0 + 31) + 31 + 128 <= tb) {
#pragma unroll
            for (int r = 0; r < 4; ++r) { s0[r] = s0[r] * QK_C + bfar; s1[r] = s1[r] * QK_C + bfar; }
        } else {
#pragma unroll
        for (int r = 0; r < 4; ++r) {
            const int na = n0 + 4 * fq + r, nb = na + 16, da = dbase - 16 * (n0 + r), db = da - 256;
            const int ia = da < 0 ? 0 : (da > 128 ? 128 : da), ib = db < 0 ? 0 : (db > 128 ? 128 : db);
            s0[r] = na < nvis ? s0[r] * QK_C + bl[ia] : NEG_INF;
            s1[r] = nb < nvis ? s1[r] * QK_C + bl[ib] : NEG_INF;
        }
        }
        float smax = fq_max(fmaxf(fmaxf(fmaxf(s0[0], s0[1]), fmaxf(s0[2], s0[3])), fmaxf(fmaxf(s1[0], s1[1]), fmaxf(s1[2], s1[3]))));
        const float mnew = fmaxf(m, smax), muse = (mnew == NEG_INF) ? 0.f : mnew;
        float ps = 0.f;
#pragma unroll
        for (int r = 0; r < 4; ++r) ps += __builtin_amdgcn_exp2f(s0[r] - muse) + __builtin_amdgcn_exp2f(s1[r] - muse);
        l = l * __builtin_amdgcn_exp2f(m - muse) + ps; m = mnew;
    }
    const float muse = (m == NEG_INF) ? 0.f : m, inv = 1.f / fmaxf(fq_sum(l), 1e-30f);
    f32x4 O[4];
#pragma unroll
    for (int dt = 0; dt < 4; ++dt) O[dt] = (f32x4){0.f, 0.f, 0.f, 0.f};
    LDS_WAIT();
    ka = ld_kt(KC, 0, F.lane); kb = ld_kt(KC, 16, F.lane);
    bf16x8 vc[4];
#pragma unroll
    for (int dt = 0; dt < 4; ++dt) vc[dt] = ld_vt(VCT, 0, dt, F.lane);
#pragma clang loop unroll(disable)
    for (int n0 = 0; n0 < nmax; n0 += 32) {
        const int nn = n0 + 32 < nmax ? n0 + 32 : n0;
        const KF nka = ld_kt(KC, nn, F.lane), nkb = ld_kt(KC, nn + 16, F.lane);
        bf16x8 nvc[4];
#pragma unroll
        for (int dt = 0; dt < 4; ++dt) nvc[dt] = ld_vt(VCT, nn, dt, F.lane);
        f32x4 s0 = qk16(ka, qf), s1 = qk16(kb, qf);
        ka = nka; kb = nkb;
        if (16 * (n0 + 31) + 31 + 128 <= tb) { const float bm = bfar - muse;
#pragma unroll
            for (int r = 0; r < 4; ++r) { s0[r] = __builtin_amdgcn_exp2f(s0[r] * QK_C + bm) * inv; s1[r] = __builtin_amdgcn_exp2f(s1[r] * QK_C + bm) * inv; }
        } else {
#pragma unroll
        for (int r = 0; r < 4; ++r) {
            const int na = n0 + 4 * fq + r, nb = na + 16, da = dbase - 16 * (n0 + r), db = da - 256;
            const int ia = da < 0 ? 0 : (da > 128 ? 128 : da), ib = db < 0 ? 0 : (db > 128 ? 128 : db);
            s0[r] = na < nvis ? __builtin_amdgcn_exp2f(s0[r] * QK_C + bl[ia] - muse) * inv : 0.f;
            s1[r] = nb < nvis ? __builtin_amdgcn_exp2f(s1[r] * QK_C + bl[ib] - muse) * inv : 0.f;
        }
        }
        const bf16x8 pf = pack_p(s0, s1);
#pragma unroll
        for (int dt = 0; dt < 4; ++dt) { O[dt] = __builtin_amdgcn_mfma_f32_16x16x32_bf16(vc[dt], pf, O[dt], 0, 0, 0); vc[dt] = nvc[dt]; }
        float x0 = (s0[0] + s0[1]) + (s0[2] + s0[3]), y0 = s0[3], x1 = (s1[0] + s1[1]) + (s1[2] + s1[3]), y1 = s1[3];
        x0 += quad_x1(x0); x0 += quad_x2(x0); y0 += quad_x1(y0); y0 += quad_x2(y0);
        x1 += quad_x1(x1); x1 += quad_x2(x1); y1 += quad_x1(y1); y1 += quad_x2(y1);
        if (z == 0) { LAS float* ip = imp + tl * 132 + (n0 >> 2) + fq;
            ip[0] = x0; ip[4] = x1; ip[528 + 1] = y0; ip[528 + 5] = y1; }
    }
    {
        const float gc = gates[(size_t)(b * SEQ + t) * 24 + hh * 3 + 0];
        const float* ow = (const float*)(F.ws + AR_OWIN) + (size_t)(b * SEQ + t) * 512 + hh * 64 + 4 * fq;
        float* op = (float*)(F.ws + AR_ORAW) + (size_t)(b * SEQ + t) * DM + 512 + hh * 64 + 4 * fq;
#pragma unroll
        for (int dt = 0; dt < 4; ++dt) *(f32x4*)(op + 16 * dt) = O[dt] * gc + *(const f32x4*)(ow + 16 * dt);
    }
    LDS_WAIT();
    const int cur = tb >> 6;
    if (cur <= 15) { if (z == 0 && fq == 0) { for (int j = 0; j <= cur; ++j) sel[tl * 16 + j] = (unsigned char)j; } }
    else {
        const int c16 = z + 4 * fq; float v[8];
#pragma unroll
        for (int i = 0; i < 8; ++i) { const int j = c16 * 8 + i; v[i] = (j >= 1 && j <= cur - 2) ? imp[tl * 132 + j] + imp[528 + tl * 132 + j] : -1.f; }
        if (c16 == 0) { sel[tl * 16 + 0] = 0; sel[tl * 16 + 14] = (unsigned char)cur; sel[tl * 16 + 15] = (unsigned char)(cur - 1); }
#pragma clang loop unroll(disable)
        for (int it = 0; it < 13; ++it) {
            float bv = v[0]; int bj = c16 * 8;
#pragma unroll
            for (int i = 1; i < 8; ++i) if (v[i] > bv) { bv = v[i]; bj = c16 * 8 + i; }
#pragma unroll
            for (int sh = 0; sh < 4; ++sh) { float ov; int oj;
                if (sh == 0) { ov = quad_x1(bv); oj = __float_as_int(quad_x1(__int_as_float(bj))); }
                else if (sh == 1) { ov = quad_x2(bv); oj = __float_as_int(quad_x2(__int_as_float(bj))); }
                else if (sh == 2) { ov = xor16f(bv); oj = __float_as_int(xor16f(__int_as_float(bj))); }
                else { ov = xor32f(bv); oj = __float_as_int(xor32f(__int_as_float(bj))); }
                if (ov > bv || (ov == bv && oj < bj)) { bv = ov; bj = oj; } }
#pragma unroll
            for (int i = 0; i < 8; ++i) if (c16 * 8 + i == bj) v[i] = -2.f;
            if (c16 == 0) sel[tl * 16 + 1 + it] = (unsigned char)bj;
        }
    }
    asm volatile("s_waitcnt vmcnt(0) lgkmcnt(0)" ::: "memory");
    LAS unsigned* msk = (LAS unsigned*)(F.lds + RING_OFF + F.wave * 8192 + 4288);
    LAS unsigned char* ulist = (LAS unsigned char*)(F.lds + RING_OFF + F.wave * 8192 + 4352);
    if (z == 0 && fq == 0) {
        unsigned w0 = 0u, w1 = 0u, w2 = 0u, w3 = 0u; const int n = cur <= 15 ? cur + 1 : 16;
        for (int i = 0; i < n; ++i) { const int j = sel[tl * 16 + i]; const unsigned bit = 1u << (j & 31);
            w0 |= (j >> 5) == 0 ? bit : 0u; w1 |= (j >> 5) == 1 ? bit : 0u; w2 |= (j >> 5) == 2 ? bit : 0u; w3 |= (j >> 5) == 3 ? bit : 0u; }
        msk[tl * 4 + 0] = w0; msk[tl * 4 + 1] = w1; msk[tl * 4 + 2] = w2; msk[tl * 4 + 3] = w3;
    }
    LDS_WAIT();
    const unsigned U0 = __builtin_amdgcn_readfirstlane(msk[0] | msk[4] | msk[8] | msk[12]), U1 = __builtin_amdgcn_readfirstlane(msk[1] | msk[5] | msk[9] | msk[13]);
    const unsigned U2 = __builtin_amdgcn_readfirstlane(msk[2] | msk[6] | msk[10] | msk[14]), U3 = __builtin_amdgcn_readfirstlane(msk[3] | msk[7] | msk[11] | msk[15]);
    const int c0n = __builtin_popcount(U0), c1n = __builtin_popcount(U1), c2n = __builtin_popcount(U2), nU = c0n + c1n + c2n + __builtin_popcount(U3);
    {   const int hi = F.lane >> 5, bb = F.lane & 31; const unsigned lowm = (1u << bb) - 1u;
        const unsigned wa = hi ? U1 : U0, wb = hi ? U3 : U2;
        if ((wa >> bb) & 1u) ulist[(hi ? c0n : 0) + __builtin_popcount(wa & lowm)] = (unsigned char)F.lane;
        if ((wb >> bb) & 1u) ulist[c0n + c1n + (hi ? c2n : 0) + __builtin_popcount(wb & lowm)] = (unsigned char)(64 + F.lane);
    }
    LDS_WAIT();
    const unsigned char* KS8 = (const unsigned char*)KS; const unsigned char* VS8 = (const unsigned char*)VST;
    long q8lo, q8hi;
    {   const u32x4 a = __builtin_bit_cast(u32x4, qf.lo), c = __builtin_bit_cast(u32x4, qf.hi);
        const unsigned l0 = cvt4_fp8(__uint_as_float(a.x << 16), __uint_as_float(a.x & 0xffff0000u), __uint_as_float(a.y << 16), __uint_as_float(a.y & 0xffff0000u));
        const unsigned l1 = cvt4_fp8(__uint_as_float(a.z << 16), __uint_as_float(a.z & 0xffff0000u), __uint_as_float(a.w << 16), __uint_as_float(a.w & 0xffff0000u));
        const unsigned h0 = cvt4_fp8(__uint_as_float(c.x << 16), __uint_as_float(c.x & 0xffff0000u), __uint_as_float(c.y << 16), __uint_as_float(c.y & 0xffff0000u));
        const unsigned h1 = cvt4_fp8(__uint_as_float(c.z << 16), __uint_as_float(c.z & 0xffff0000u), __uint_as_float(c.w << 16), __uint_as_float(c.w & 0xffff0000u));
        q8lo = (long)(((unsigned long long)l1 << 32) | l0); q8hi = (long)(((unsigned long long)h1 << 32) | h0); }
    struct SelStep { u32x4 k[2]; u32x4 v[2]; };
    const int l8 = fq * 256 + fr * 16;
#define SEL_LOADK(B, k0_) do { const int _k0 = (k0_); B.k[0] = *(const u32x4*)(KS8 + (size_t)(_k0 >> 4) * 1024 + l8); B.k[1] = *(const u32x4*)(KS8 + (size_t)((_k0 >> 4) + 1) * 1024 + l8); } while (0)
#define SEL_LOADV(V, k0_) do { const int _k0 = (k0_); V[0] = *(const u32x4*)(VS8 + (size_t)(_k0 >> 5) * 2048 + l8); V[1] = *(const u32x4*)(VS8 + (size_t)(_k0 >> 5) * 2048 + 1024 + l8); } while (0)
#define U2L(lo_, hi_) ((long)(((unsigned long long)(hi_) << 32) | (unsigned long long)(lo_)))
#define QK8(KK) __builtin_amdgcn_mfma_f32_16x16x32_fp8_fp8(U2L(KK.z, KK.w), q8hi, __builtin_amdgcn_mfma_f32_16x16x32_fp8_fp8(U2L(KK.x, KK.y), q8lo, (f32x4){0.f, 0.f, 0.f, 0.f}, 0, 0, 0), 0, 0, 0)
#define SEL_LOGITS(B, k0_, cv_, s0, s1) do { s0 = QK8(B.k[0]); s1 = QK8(B.k[1]); \
        if ((k0_) + 31 + 128 <= tb) { const float bb_ = (cv_) ? bfar : NEG_INF; _Pragma("unroll") for (int r = 0; r < 4; ++r) { s0[r] = s0[r] * QK_C + bb_; s1[r] = s1[r] * QK_C + bb_; } } \
        else { const int d0 = t - ((k0_) + 4 * fq); \
            _Pragma("unroll") for (int r = 0; r < 4; ++r) { const int da = d0 - r, db = d0 - 16 - r; \
                const int ia = da < 0 ? 0 : (da > 128 ? 128 : da), ib = db < 0 ? 0 : (db > 128 ? 128 : db); \
                s0[r] = ((cv_) && da >= 0) ? s0[r] * QK_C + bl[ia] : NEG_INF; s1[r] = ((cv_) && db >= 0) ? s1[r] * QK_C + bl[ib] : NEG_INF; } } } while (0)
#define SEL_K0(q_, ka_, kb_, va_, vb_) do { const int _p = (q_) >> 1, _h = (q_) & 1; const int _ja = __builtin_amdgcn_readfirstlane((int)ulist[2 * _p]); \
        const bool _hb = 2 * _p + 1 < nU; const int _jb = _hb ? __builtin_amdgcn_readfirstlane((int)ulist[2 * _p + 1]) : _ja; \
        ka_ = 64 * _ja + 32 * _h; kb_ = 64 * _jb + 32 * _h; va_ = ((msk[tl * 4 + (_ja >> 5)] >> (_ja & 31)) & 1u) != 0u; vb_ = _hb && (((msk[tl * 4 + (_jb >> 5)] >> (_jb & 31)) & 1u) != 0u); } while (0)
#define PV8(OO, VV, PP) do { OO[0] = __builtin_amdgcn_mfma_f32_16x16x32_fp8_fp8(U2L(VV[0].x, VV[0].y), PP, OO[0], 0, 0, 0); OO[1] = __builtin_amdgcn_mfma_f32_16x16x32_fp8_fp8(U2L(VV[0].z, VV[0].w), PP, OO[1], 0, 0, 0); \
        OO[2] = __builtin_amdgcn_mfma_f32_16x16x32_fp8_fp8(U2L(VV[1].x, VV[1].y), PP, OO[2], 0, 0, 0); OO[3] = __builtin_amdgcn_mfma_f32_16x16x32_fp8_fp8(U2L(VV[1].z, VV[1].w), PP, OO[3], 0, 0, 0); } while (0)
#define SEL_STEP(CA_, CB_, NA_, NB_, q_) do { int na0 = ka0, nb0 = kb0; bool nva = cva, nvb = cvb; if ((q_) + 1 < nstep) SEL_K0((q_) + 1, na0, nb0, nva, nvb); \
        SEL_LOADK(NA_, na0); SEL_LOADK(NB_, nb0); SEL_LOADV(NA_.v, na0); SEL_LOADV(NB_.v, nb0); \
        f32x4 sa0, sa1, sb0, sb1; SEL_LOGITS(CA_, ka0, cva, sa0, sa1); SEL_LOGITS(CB_, kb0, cvb, sb0, sb1); \
        long pa, pb; osm_step8x2(sa0, sa1, mA, lA, OA, sb0, sb1, mB, lB, OB, pa, pb); \
        PV8(OA, CA_.v, pa); PV8(OB, CB_.v, pb); \
        ka0 = na0; kb0 = nb0; cva = nva; cvb = nvb; } while (0)
    {
        const int nstep = 2 * ((nU + 1) >> 1);
        float mA = NEG_INF, lA = 0.f, mB = NEG_INF, lB = 0.f; f32x4 OA[4], OB[4];
#pragma unroll
        for (int dt = 0; dt < 4; ++dt) { OA[dt] = (f32x4){0.f, 0.f, 0.f, 0.f}; OB[dt] = (f32x4){0.f, 0.f, 0.f, 0.f}; }
        SelStep XA, XB, YA, YB; int ka0, kb0; bool cva, cvb;
        SEL_K0(0, ka0, kb0, cva, cvb); SEL_LOADK(XA, ka0); SEL_LOADK(XB, kb0); SEL_LOADV(XA.v, ka0); SEL_LOADV(XB.v, kb0);
#pragma clang loop unroll(disable)
        for (int q = 0; q < nstep; q += 2) { SEL_STEP(XA, XB, YA, YB, q); SEL_STEP(YA, YB, XA, XB, q + 1); }
        const float mm = fmaxf(mA, mB), mu = (mm == NEG_INF) ? 0.f : mm, fa = __builtin_amdgcn_exp2f(mA - mu), fb = __builtin_amdgcn_exp2f(mB - mu);
        const float lt = fq_sum(lA * fa + lB * fb);
        const float sc = gates[(size_t)(b * SEQ + t) * 24 + hh * 3 + 1] / fmaxf(lt, 1e-30f);
        float* op = (float*)(F.ws + AR_ORAW) + (size_t)(b * SEQ + t) * DM + 512 + hh * 64 + 4 * fq;
#pragma unroll
        for (int dt = 0; dt < 4; ++dt) { const f32x4 prev = *(const f32x4*)(op + 16 * dt); *(f32x4*)(op + 16 * dt) = prev + (OA[dt] * fa + OB[dt] * fb) * sc; }
    }
#undef U2L
#undef QK8
#undef PV8
#undef SEL_LOADK
#undef SEL_LOADV
#undef SEL_LOGITS
#undef SEL_K0
#undef SEL_STEP
    LDS_WAIT();
}

constexpr int NPH_L = 9, NPHASES = 2 + 2 * NPH_L;

#define IN(k) (lo <= (k) && (k) < hi)
#if MK_SINGLE
#define SEAM(k) do { if (IN(k) && IN((k) + 1)) xcd_barrier(bar); } while (0)
#else
#define SEAM(k) do { } while (0)
#endif
template <int layer>
__device__ __forceinline__ void layer_body(Frame& F, const Args& args, const XcdBarrier& bar, const int lo, const int hi) {
        const int pb = 2 + layer * NPH_L;
#ifndef NO_GEMM
        if (IN(pb + 0)) {
            pg8::Gemm g{(const bf16*)(args.ws + WS_H), (const bf16*)(args.ws + WS_WIN) + (size_t)layer * NPROJ * DM, T, NPROJ, DM};
            pg8::ProjOrder S; S.init(T, NPROJ, F.G, (int)blockIdx.x);
            pg8::EpiProj E{(bf16*)(args.ws + AR_SBQ), (float*)(args.ws + AR_GATES)};
            pg8::gemm_phase<pg8::EpiProj, pg8::ProjOrder, true, 0, true>(F.lds + RING_OFF, g, nullptr, S, E);
        }
#endif
        SEAM(pb + 0);
        if (IN(pb + 1)) {
            if (F.vcu < 16) {
                pg8::Gemm g{(const bf16*)(args.ws + AR_NKV), (const bf16*)(args.ws + WS_CW1) + (size_t)layer * 2 * 256 * 2048, 4096, 512, 2048};
                pg8::CmpOrder S{F.G, F.vcu};
                pg8::EpiCmpHid E{(bf16*)(args.ws + AR_CHID), (const float*)(args.ws + WS_CBIAS) + (size_t)layer * 2 * 256};
                pg8::gemm_phase<pg8::EpiCmpHid, pg8::CmpOrder, false, 2>(F.lds + RING_OFF, g, nullptr, S, E);
                asm volatile("s_waitcnt vmcnt(0)" ::: "memory"); __syncthreads();
                cmp_out_unit(F, layer, F.vcu);
            }
#ifndef NO_WIN
            if (F.G == 256) {
                const int wv = F.vcu * NWAVES + F.wave;
                if (wv < 128) win_task(F, ((wv >> 5) << 9) | (wv & 31));
                else { const int r = wv - 128; win_task(F, ((r / 480) << 9) | (32 + r % 480)); }
            } else { for (int task = F.vcu * NWAVES + F.wave; task < 2048; task += F.G * NWAVES) win_task(F, task); }
#endif
#ifndef NO_SB
            {
                const int nw = (F.G - 16) * NWAVES, per = nw > 0 ? 8192 / nw : 0, nstat = per * nw;
                if (F.vcu >= 16) { for (int k = 0; k < per; ++k) sb_task(F, (F.vcu - 16) * NWAVES + F.wave + k * nw); }
                unsigned* qs = (unsigned*)(args.ws + WS_CTL) + CW_QUEUE + 128 + layer * 64;
                for (;;) {
                    unsigned q = 0; if (F.lane == 0) q = __hip_atomic_fetch_add(qs, 1u, __ATOMIC_RELAXED, __HIP_MEMORY_SCOPE_AGENT);
                    q = __builtin_amdgcn_readfirstlane(q);
                    if (nstat + q >= 8192u) break;
                    sb_task(F, nstat + (int)q);
                }
            }
#endif
        }
        SEAM(pb + 1);
#ifndef NO_NSA
        if (IN(pb + 2)) {
            unsigned* qh = (unsigned*)(args.ws + WS_CTL) + CW_QUEUE + layer * 64;
            for (;;) {
                unsigned q = 0; if (F.lane == 0) q = __hip_atomic_fetch_add(qh, 1u, __ATOMIC_RELAXED, __HIP_MEMORY_SCOPE_AGENT);
                q = __builtin_amdgcn_readfirstlane(q);
                if (q >= 8192u) break;
                nsa_task(F, (int)q);
            }
        }
#endif
        SEAM(pb + 2);
        if (IN(pb + 3)) { phase_merge(F, layer); }
        SEAM(pb + 3);
#ifndef NO_GEMM
        if (IN(pb + 4)) {
            pg8::Gemm g{(const bf16*)(args.ws + WS_H), (const bf16*)(args.ws + WS_WOUT) + (size_t)layer * DM * DM, T, DM, DM};
            pg8::StaticOrder S; S.init(T, DM, F.G, (int)blockIdx.x);
            pg8::EpiOutBf16 E{(bf16*)(args.ws + AR_M), DM};
            pg8::gemm_phase<pg8::EpiOutBf16, pg8::StaticOrder, false, 0>(F.lds + RING_OFF, g, nullptr, S, E);
        }
#endif
        SEAM(pb + 4);
#ifndef NO_THIN
        if (IN(pb + 5)) { phase_post_mix(F, layer); }
#endif
        SEAM(pb + 5);
#ifndef NO_GEMM
        if (IN(pb + 6)) {
            if (layer == 0) {
                pg8::Gemm g{(const bf16*)(args.ws + WS_H), (const bf16*)(args.ws + WS_FGU), T, 2 * DFF, DM};
                pg8::StaticOrder S; S.init(T, 2 * DFF, F.G, (int)blockIdx.x);
                pg8::EpiSwiglu E{(bf16*)(args.ws + AR_FHID), DFF, DFF / 128};
                pg8::gemm_phase<pg8::EpiSwiglu, pg8::StaticOrder, true, 0>(F.lds + RING_OFF, g, nullptr, S, E);
            } else {
                moe_table_build(F); const LAS int* tbl = (const LAS int*)(F.lds + MOETBL_OFF);
#define NTL(e) __builtin_amdgcn_readfirstlane(tbl[16 + (e)])
#define CNL(e) __builtin_amdgcn_readfirstlane(tbl[8 + (e)])
                pg8::Gemm g{(const bf16*)(args.ws + WS_H), (const bf16*)(args.ws + WS_MGU), MOE_ROWS, NE * 2 * DFE, DM};
                pg8::MoeOrder S{NTL(0), NTL(1), NTL(2), NTL(3), NTL(4), NTL(5), NTL(6), NTL(7), 2 * DFE / 256, F.G, F.vcu, CNL(0), CNL(1), CNL(2), CNL(3), CNL(4), CNL(5), CNL(6), CNL(7)};
                pg8::EpiSwiglu E{(bf16*)(args.ws + AR_HIDM), DFE, DFE / 128};
                pg8::gemm_phase<pg8::EpiSwiglu, pg8::MoeOrder, true, 1>(F.lds + RING_OFF, g, (const int*)(args.ws + AR_ROWTOK), S, E);
            }
        }
#endif
        SEAM(pb + 6);
#ifndef NO_GEMM
        if (IN(pb + 7)) {
            if (layer == 0) {
                pg8::Gemm g{(const bf16*)(args.ws + AR_FHID), (const bf16*)(args.ws + WS_FD), T, DM, DFF};
                pg8::StaticOrder S; S.init(T, DM, F.G, (int)blockIdx.x);
                pg8::EpiOutBf16 E{(bf16*)(args.ws + AR_FOUT), DM};
                pg8::gemm_phase<pg8::EpiOutBf16, pg8::StaticOrder, false, 0>(F.lds + RING_OFF, g, nullptr, S, E);
            } else {
                moe_table_build(F); const LAS int* tbl = (const LAS int*)(F.lds + MOETBL_OFF);
                pg8::Gemm g{(const bf16*)(args.ws + AR_HIDM), (const bf16*)(args.ws + WS_MD), MOE_ROWS, NE * DM, DFE};
                const int nfull = __builtin_amdgcn_readfirstlane(tbl[24]), nS = __builtin_amdgcn_readfirstlane(tbl[25]);
                pg8::MoeDownOrder S{NTL(0), NTL(1), NTL(2), NTL(3), NTL(4), NTL(5), NTL(6), NTL(7), DM / 256, F.G, F.vcu, nfull, nS, DFE / 64};
                pg8::EpiMoeDown E{(bf16*)(args.ws + WS_Y), (bf16*)(args.ws + WS_YPART), nfull * 256};
                pg8::gemm_phase<pg8::EpiMoeDown, pg8::MoeDownOrder, true, 0>(F.lds + RING_OFF, g, nullptr, S, E);
            }
        }
#endif
        SEAM(pb + 7);
#ifndef NO_THIN
        if (IN(pb + 8)) { phase_post_ffn(F, layer); }
#endif
        SEAM(pb + 8);

}
__global__ void __launch_bounds__(NTHR, 2) mega(Args args) {
    extern __shared__ __attribute__((aligned(16))) unsigned char lds_raw[];
    Frame F;
    F.lds = (LAS unsigned char*)lds_raw; F.a = &args; F.ws = args.ws;
    F.tid = threadIdx.x; F.lane = F.tid & 63; F.wave = __builtin_amdgcn_readfirstlane(F.tid >> 6);
    F.G = gridDim.x; { const int bx = blockIdx.x; F.vcu = (F.G % 8 == 0) ? (bx % 8) * (F.G / 8) + bx / 8 : bx; }
    if (F.tid < 4) ((LAS unsigned*)(F.lds + LDSCTL_OFF))[F.tid] = 0u;
    if (F.tid < 128) { const int n = F.tid; int bk = n;
        if (n >= 16) { bk = 16 + (int)(__log2f((float)n * (1.f / 16.f)) * (16.f / 3.f)); bk = bk > 31 ? 31 : bk; }
        ((LAS unsigned char*)(F.lds + LDSCTL_OFF + 64))[n] = (unsigned char)bk; }
    if (F.tid < 256) ((LAS float*)(F.lds + LDSCTL_OFF + 256))[F.tid] = args.in[2][F.tid];
    __syncthreads();
    for (int i = F.tid; i < 8 * 132; i += NTHR) { const int hh = i / 132, d = i % 132; const int bk = d < 128 ? (int)((LAS unsigned char*)(F.lds + LDSCTL_OFF + 64))[d] : 31;
        ((LAS float*)(F.lds + BIASL_OFF))[i] = ((LAS float*)(F.lds + LDSCTL_OFF + 256))[bk * 8 + hh] * 1.4426950408889634f; }
    __syncthreads();
    unsigned* ctl = (unsigned*)(args.ws + WS_CTL);
#if MK_SINGLE
    XcdBarrier bar = xcd_barrier_post(ctl + CW_BAR, (volatile LAS unsigned*)(F.lds + LDSCTL_OFF));
#else
    XcdBarrier bar; bar.bar = ctl; bar.x = 0; bar.st = nullptr;
#endif
    const int lo = args.ph_lo, hi = args.ph_hi;
#ifndef NO_PRO
    if (IN(0)) { phase_prologue(F); }
#endif
    SEAM(0);
    if (IN(1)) { phase_h0(F); } SEAM(1);
    layer_body<0>(F, args, bar, lo, hi);
    layer_body<1>(F, args, bar, lo, hi);
#undef IN
#undef SEAM
}


extern "C" void kernel_launch(void* const* d_in, const int* in_sizes, int n_in, void* d_out, int out_size, void* d_ws, size_t ws_size, hipStream_t stream) {
    static int grid = 0;
    if (grid == 0) {
        if (n_in != 27 || out_size != T * DM || ws_size < WS_END) { fprintf(stderr, "kernel_launch: unexpected problem (n_in %d out %d ws %zu)\n", n_in, out_size, ws_size); grid = -1; return; }
        int dev = 0, cus = 0, per_cu = 0;
        if (hipGetDevice(&dev) != hipSuccess || hipDeviceGetAttribute(&cus, hipDeviceAttributeMultiprocessorCount, dev) != hipSuccess) { grid = -1; return; }
        if (hipFuncSetAttribute((const void*)mega, hipFuncAttributeMaxDynamicSharedMemorySize, LDS_BYTES) != hipSuccess) { fprintf(stderr, "kernel_launch: hipFuncSetAttribute failed\n"); grid = -1; return; }
        if (hipOccupancyMaxActiveBlocksPerMultiprocessor(&per_cu, (const void*)mega, NTHR, LDS_BYTES) != hipSuccess || per_cu < 1) { fprintf(stderr, "kernel_launch: occupancy query says %d\n", per_cu); }
        (void)hipGetLastError();
        grid = cus;
    }
    if (grid < 0) return;
    if (hipMemsetAsync((char*)d_ws + WS_CTL, 0, CTL_ZERO_BYTES, stream) != hipSuccess) return;
    Args a{};
    for (int i = 0; i < 27; ++i) a.in[i] = (const float*)d_in[i];
    a.out = (float*)d_out; a.ws = (unsigned char*)d_ws;
#if MK_SINGLE
    a.ph_lo = 0; a.ph_hi = NPHASES;
    hipLaunchKernelGGL(mega, dim3(grid), dim3(NTHR), LDS_BYTES, stream, a);
#else
#ifndef MK_MAXPH
#define MK_MAXPH NPHASES
#endif
    for (int p = 0; p < MK_MAXPH; ++p) {
        a.ph_lo = p; a.ph_hi = p + 1;
        hipLaunchKernelGGL(mega, dim3(grid), dim3(NTHR), LDS_BYTES, stream, a);
    }
#endif
}
```
